# Optimizing an MI355X kernel written in HIP

```python
import jax, jax.numpy as jnp
from jax import lax
import numpy as np

D_MODEL = 1024
BATCH = 8
SEQ = 4096
DEPTH = 4

CTX_LEN = 256
GRID_W = 64
HEAD_DIM = 64
BLOCK = 128
MIX_W = 512
N_BRANCH = 3
A_GROUPS = 4
A_GROUP_W = MIX_W // A_GROUPS
B_HEADS = 4
B_VDIM = 2 * HEAD_DIM
C_Q_HEADS = 8
C_KV_HEADS = 2
C_GROUP = C_Q_HEADS // C_KV_HEADS
C_WINDOW = 128
D_FF = 2816
CONV_W = 3
ROPE_BASE = 10000.0
EPS = 1e-6
SCALE = HEAD_DIM ** -0.5
NEG_INF = -1e30
IN_SIZES = (MIX_W, MIX_W,
            2 * B_HEADS * HEAD_DIM, 2 * B_HEADS * HEAD_DIM,
            B_HEADS * B_VDIM,
            C_Q_HEADS * HEAD_DIM,
            C_KV_HEADS * HEAD_DIM, C_KV_HEADS * HEAD_DIM,
            N_BRANCH * D_MODEL)
IN_WIDTH = 6400

kernel_name = 'hybrid_prefix_dit_block'


def rmsnorm(x, g):
    xf = x.astype(jnp.float32)
    y = xf * lax.rsqrt(jnp.mean(xf * xf, axis=-1, keepdims=True) + EPS)
    return (y * g.astype(jnp.float32)).astype(x.dtype)


def layernorm(x, g, b):
    xf = x.astype(jnp.float32)
    mu = jnp.mean(xf, axis=-1, keepdims=True)
    var = jnp.mean(jnp.square(xf - mu), axis=-1, keepdims=True)
    y = (xf - mu) * lax.rsqrt(var + EPS)
    return (y * g.astype(jnp.float32) + b.astype(jnp.float32)).astype(x.dtype)


def ada_params(v, w, b):
    m = (jax.nn.silu(v) @ w + b)[:, None, :]
    return jnp.split(m, 6, axis=-1)


def split_cols(p):
    outs = []
    start = 0
    for size in IN_SIZES:
        outs.append(p[..., start:start + size])
        start += size
    return outs


def rope_tables(length):
    rows_n = length // GRID_W
    rows = jnp.repeat(jnp.arange(rows_n), GRID_W).astype(jnp.float32)
    cols = jnp.tile(jnp.arange(GRID_W), rows_n).astype(jnp.float32)
    half = HEAD_DIM // 2
    inv = ROPE_BASE ** (-jnp.arange(0, half, 2, dtype=jnp.float32) / half)
    ang_r = rows[:, None] * inv[None, :]
    ang_c = cols[:, None] * inv[None, :]
    return (jnp.cos(ang_r), jnp.sin(ang_r), jnp.cos(ang_c), jnp.sin(ang_c))


def _rot(xh, cos, sin):
    x1, x2 = jnp.split(xh, 2, axis=-1)
    cos = cos[None, :, None, :]
    sin = sin[None, :, None, :]
    return jnp.concatenate([x1 * cos - x2 * sin, x2 * cos + x1 * sin], axis=-1)


def apply_rope(x, tables):
    cos_r, sin_r, cos_c, sin_c = tables
    xf = x.astype(jnp.float32)
    xr, xc = jnp.split(xf, 2, axis=-1)
    return jnp.concatenate([_rot(xr, cos_r, sin_r), _rot(xc, cos_c, sin_c)], axis=-1).astype(x.dtype)


def spatial_gating(u, v, ln_g, ln_b, w_s, b_s):
    bsz, length, _ = u.shape
    u = jax.nn.gelu(u)
    vn = layernorm(jax.nn.gelu(v), ln_g, ln_b)
    vz = vn.reshape(bsz, length // BLOCK, BLOCK, A_GROUPS, A_GROUP_W)
    mixed = jnp.einsum('gpq,bnqgc->bnpgc', w_s, vz) + b_s.T[None, None, :, :, None]
    return u * mixed.reshape(bsz, length, MIX_W)


def diff_core(q, k, v, lam):
    s = jnp.einsum('bqhmd,bkhmd->bhmqk', q, k).astype(jnp.float32) * SCALE
    p = jax.nn.softmax(s, axis=-1)
    a = p[:, :, 0] - lam * p[:, :, 1]
    return jnp.einsum('bhqk,bkhe->bqhe', a.astype(v.dtype), v)


def diff_post(o, sub_g, lam_init):
    bsz, length = o.shape[:2]
    return (rmsnorm(o, sub_g) * (1.0 - lam_init)).reshape(bsz, length, MIX_W)


def diff_attention_latent(q, k, v, k_ctx, v_ctx, lam):
    bsz, length = q.shape[:2]
    n_blk = length // BLOCK
    k_all = jnp.concatenate([k, k_ctx], axis=1)
    v_all = jnp.concatenate([v, v_ctx], axis=1)
    qb = q.reshape(bsz, n_blk, BLOCK, B_HEADS, 2, HEAD_DIM).swapaxes(0, 1)
    ob = lax.map(lambda qblk: diff_core(qblk, k_all, v_all, lam), qb)
    return ob.swapaxes(0, 1).reshape(bsz, length, B_HEADS, B_VDIM)


def window_gqa_latent(q, k, v, k_ctx, v_ctx, sink):
    bsz, length = q.shape[:2]
    n_blk = length // BLOCK
    qg = q.reshape(bsz, n_blk, BLOCK, C_KV_HEADS, C_GROUP, HEAD_DIM).swapaxes(0, 1)
    pad = ((0, 0), (BLOCK, BLOCK), (0, 0), (0, 0))
    k_pad = jnp.pad(k, pad)
    v_pad = jnp.pad(v, pad)
    sink_f = sink.astype(jnp.float32).reshape(C_KV_HEADS, C_GROUP)
    n_ctx = k_ctx.shape[1]

    def block(args):
        qblk, n = args
        start = n * BLOCK
        kb = lax.dynamic_slice_in_dim(k_pad, start, 3 * BLOCK, axis=1)
        vb = lax.dynamic_slice_in_dim(v_pad, start, 3 * BLOCK, axis=1)
        qpos = start + jnp.arange(BLOCK)
        kpos = start - BLOCK + jnp.arange(3 * BLOCK)
        rel = kpos[None, :] - qpos[:, None]
        valid = (jnp.abs(rel) <= C_WINDOW) & (kpos >= 0)[None, :] & (kpos < length)[None, :]
        s_loc = jnp.einsum('bqkgd,bjkd->bkgqj', qblk, kb).astype(jnp.float32) * SCALE
        s_loc = jnp.where(valid, s_loc, NEG_INF)
        s_ctx = jnp.einsum('bqkgd,bjkd->bkgqj', qblk, k_ctx).astype(jnp.float32) * SCALE
        s_sink = jnp.broadcast_to(sink_f[None, :, :, None, None], s_loc.shape[:-1] + (1,))
        p = jax.nn.softmax(jnp.concatenate([s_loc, s_ctx, s_sink], axis=-1), axis=-1)
        p_loc = p[..., :3 * BLOCK].astype(v.dtype)
        p_ctx = p[..., 3 * BLOCK:3 * BLOCK + n_ctx].astype(v.dtype)
        return (jnp.einsum('bkgqj,bjkd->bqkgd', p_loc, vb)
                + jnp.einsum('bkgqj,bjkd->bqkgd', p_ctx, v_ctx))

    out = lax.map(block, (qg, jnp.arange(n_blk)))
    return out.swapaxes(0, 1).reshape(bsz, length, MIX_W)


def window_gqa_context(q, k, v, sink):
    bsz, length = q.shape[:2]
    sink_f = sink.astype(jnp.float32).reshape(C_KV_HEADS, C_GROUP)
    s = jnp.einsum('bqkgd,bjkd->bkgqj', q, k).astype(jnp.float32) * SCALE
    s_sink = jnp.broadcast_to(sink_f[None, :, :, None, None], s.shape[:-1] + (1,))
    p = jax.nn.softmax(jnp.concatenate([s, s_sink], axis=-1), axis=-1)[..., :-1]
    out = jnp.einsum('bkgqj,bjkd->bqkgd', p.astype(v.dtype), v)
    return out.reshape(bsz, length, MIX_W)


def merge_branches(outs, gates, w_branch, w_out):
    bsz, length = gates.shape[:2]
    g = jax.nn.sigmoid(gates.reshape(bsz, length, N_BRANCH, D_MODEL))
    y = g[:, :, 0] * (outs[0] @ w_branch[0])
    for i in range(1, N_BRANCH):
        y = y + g[:, :, i] * (outs[i] @ w_branch[i])
    return y @ w_out


def conv_ffn(h, w_gate, conv_w, conv_b, w_up, w_down):
    a = h @ w_gate
    ap = jnp.pad(a, ((0, 0), (1, 1), (0, 0)))
    a = ap[:, :-2] * conv_w[0] + ap[:, 1:-1] * conv_w[1] + ap[:, 2:] * conv_w[2] + conv_b
    return (jax.nn.silu(a) * (h @ w_up)) @ w_down


def setup_inputs(seed: int = 0) -> dict:
    key = jax.random.key(seed)
    ks = jax.random.split(key, 32)

    def nrm(k, shape, scale):
        return jax.random.normal(k, shape, jnp.float32) * scale

    D = D_MODEL
    return {
        'x': nrm(ks[0], (BATCH, SEQ, D), 1.0),
        'c': nrm(ks[1], (BATCH, D), 1.0),
        'ctx': nrm(ks[2], (BATCH, CTX_LEN, D), 1.0),
        'c_ctx': nrm(ks[3], (D,), 1.0),
        'w_ada': nrm(ks[4], (DEPTH, D, 6 * D), 0.5 * D ** -0.5),
        'b_ada': nrm(ks[5], (DEPTH, 6 * D), 0.01),
        'norm1_g': 1.0 + nrm(ks[6], (DEPTH, D), 0.02),
        'w_in': nrm(ks[7], (DEPTH, D, IN_WIDTH), D ** -0.5),
        'sgu_ln_g': 1.0 + nrm(ks[8], (DEPTH, MIX_W), 0.02),
        'sgu_ln_b': nrm(ks[9], (DEPTH, MIX_W), 0.02),
        'w_s': nrm(ks[10], (DEPTH, A_GROUPS, BLOCK, BLOCK), BLOCK ** -0.5),
        'b_s': 1.0 + nrm(ks[11], (DEPTH, A_GROUPS, BLOCK), 0.02),
        'lam_q1': nrm(ks[12], (DEPTH, HEAD_DIM), 0.1),
        'lam_k1': nrm(ks[13], (DEPTH, HEAD_DIM), 0.1),
        'lam_q2': nrm(ks[14], (DEPTH, HEAD_DIM), 0.1),
        'lam_k2': nrm(ks[15], (DEPTH, HEAD_DIM), 0.1),
        'diff_subln_g': 1.0 + nrm(ks[16], (DEPTH, B_VDIM), 0.02),
        'sinks': nrm(ks[17], (DEPTH, C_Q_HEADS), 0.5),
        'w_branch': nrm(ks[18], (DEPTH, N_BRANCH, MIX_W, D), MIX_W ** -0.5),
        'w_out': nrm(ks[19], (DEPTH, D, D), D ** -0.5),
        'norm2_g': 1.0 + nrm(ks[20], (DEPTH, D), 0.02),
        'w_gate': nrm(ks[21], (DEPTH, D, D_FF), D ** -0.5),
        'conv_w': nrm(ks[22], (DEPTH, CONV_W, D_FF), CONV_W ** -0.5),
        'conv_b': nrm(ks[23], (DEPTH, D_FF), 0.01),
        'w_up': nrm(ks[24], (DEPTH, D, D_FF), D ** -0.5),
        'w_down': nrm(ks[25], (DEPTH, D_FF, D), D_FF ** -0.5),
        'final_g': 1.0 + nrm(ks[26], (D,), 0.02),
    }


def reference(x, c, ctx, c_ctx, w_ada, b_ada, norm1_g, w_in, sgu_ln_g, sgu_ln_b, w_s, b_s,
              lam_q1, lam_k1, lam_q2, lam_k2, diff_subln_g, sinks, w_branch, w_out,
              norm2_g, w_gate, conv_w, conv_b, w_up, w_down, final_g):
    bsz, length, _ = x.shape
    n_ctx = ctx.shape[1]
    tables = rope_tables(length)
    for l in range(DEPTH):
        last = l == DEPTH - 1
        sh1, sc1, g1, sh2, sc2, g2 = ada_params(c, w_ada[l], b_ada[l])
        csh1, csc1, cg1, csh2, csc2, cg2 = ada_params(c_ctx[None, :], w_ada[l], b_ada[l])

        h = rmsnorm(x, norm1_g[l]) * (1.0 + sc1) + sh1
        hc = rmsnorm(ctx, norm1_g[l]) * (1.0 + csc1) + csh1
        a_u, a_v, b_q, b_k, b_v, c_q, c_k, c_v, gates = split_cols(h @ w_in[l])
        ca_u, ca_v, cb_q, cb_k, cb_v, cc_q, cc_k, cc_v, cgates = split_cols(hc @ w_in[l])

        o_a = spatial_gating(a_u, a_v, sgu_ln_g[l], sgu_ln_b[l], w_s[l], b_s[l])

        lam_init = 0.8 - 0.6 * float(np.exp(-0.3 * l))
        lam = (jnp.exp(jnp.sum(lam_q1[l] * lam_k1[l]).astype(jnp.float32))
               - jnp.exp(jnp.sum(lam_q2[l] * lam_k2[l]).astype(jnp.float32)) + lam_init)
        qb = apply_rope(b_q.reshape(bsz, length, 2 * B_HEADS, HEAD_DIM), tables)
        kb = apply_rope(b_k.reshape(bsz, length, 2 * B_HEADS, HEAD_DIM), tables)
        qb = qb.reshape(bsz, length, B_HEADS, 2, HEAD_DIM)
        kb = kb.reshape(bsz, length, B_HEADS, 2, HEAD_DIM)
        vb = b_v.reshape(bsz, length, B_HEADS, B_VDIM)
        cqb = cb_q.reshape(bsz, n_ctx, B_HEADS, 2, HEAD_DIM)
        ckb = cb_k.reshape(bsz, n_ctx, B_HEADS, 2, HEAD_DIM)
        cvb = cb_v.reshape(bsz, n_ctx, B_HEADS, B_VDIM)
        o_b = diff_post(diff_attention_latent(qb, kb, vb, ckb, cvb, lam), diff_subln_g[l], lam_init)

        qc = apply_rope(c_q.reshape(bsz, length, C_Q_HEADS, HEAD_DIM), tables)
        qc = qc.reshape(bsz, length, C_KV_HEADS, C_GROUP, HEAD_DIM)
        kc = apply_rope(c_k.reshape(bsz, length, C_KV_HEADS, HEAD_DIM), tables)
        vc = c_v.reshape(bsz, length, C_KV_HEADS, HEAD_DIM)
        ckc = cc_k.reshape(bsz, n_ctx, C_KV_HEADS, HEAD_DIM)
        cvc = cc_v.reshape(bsz, n_ctx, C_KV_HEADS, HEAD_DIM)
        o_c = window_gqa_latent(qc, kc, vc, ckc, cvc, sinks[l])

        x = x + g1 * merge_branches((o_a, o_b, o_c), gates, w_branch[l], w_out[l])

        if not last:
            co_a = spatial_gating(ca_u, ca_v, sgu_ln_g[l], sgu_ln_b[l], w_s[l], b_s[l])
            co_b = diff_post(diff_core(cqb, ckb, cvb, lam), diff_subln_g[l], lam_init)
            cqc = cc_q.reshape(bsz, n_ctx, C_KV_HEADS, C_GROUP, HEAD_DIM)
            co_c = window_gqa_context(cqc, ckc, cvc, sinks[l])
            ctx = ctx + cg1 * merge_branches((co_a, co_b, co_c), cgates, w_branch[l], w_out[l])

        h2 = rmsnorm(x, norm2_g[l]) * (1.0 + sc2) + sh2
        x = x + g2 * conv_ffn(h2, w_gate[l], conv_w[l], conv_b[l], w_up[l], w_down[l])
        if not last:
            hc2 = rmsnorm(ctx, norm2_g[l]) * (1.0 + csc2) + csh2
            ctx = ctx + cg2 * conv_ffn(hc2, w_gate[l], conv_w[l], conv_b[l], w_up[l], w_down[l])

    return rmsnorm(x, final_g)
```

```cpp
#include <hip/hip_runtime.h>
#include <hip/hip_cooperative_groups.h>
#include <cstdio>
#include <cstdint>
namespace cg = cooperative_groups;

#define DI __device__ __forceinline__
typedef unsigned short bf16_t;
typedef short bf16x8 __attribute__((ext_vector_type(8)));
typedef short s16x4 __attribute__((ext_vector_type(4)));
typedef short v4i16_t __attribute__((ext_vector_type(4)));
typedef float f32x4 __attribute__((ext_vector_type(4)));
typedef float f32x16 __attribute__((ext_vector_type(16)));
typedef unsigned u32x4 __attribute__((ext_vector_type(4)));
typedef unsigned u32x2 __attribute__((ext_vector_type(2)));
typedef float f32x2_t __attribute__((ext_vector_type(2)));
typedef __bf16 bf16x2_t __attribute__((ext_vector_type(2)));

constexpr int DM = 1024, NBATCH = 8, SEQ = 4096, NCTX = 256, DEPTH = 4;
constexpr int NLAT = NBATCH * SEQ;
constexpr int NCTXR = NBATCH * NCTX;
constexpr int MTOT = NLAT + NCTXR;
constexpr int INW = 6400, LDP = 6464;
constexpr int HALF_LAT = NLAT / 2, HALF_CTX = NCTXR / 2, MH = HALF_LAT + HALF_CTX;
constexpr int DFF = 2816;
constexpr int COL_AU = 0, COL_AV = 512, COL_BQ = 1024, COL_BK = 1536, COL_BV = 2048, COL_CQ = 2560, COL_CK = 3072, COL_CV = 3200, COL_G = 3328;
constexpr float EPS = 1e-6f;
constexpr float LOG2E = 1.4426950408889634f;
constexpr float SM_C = 0.125f * LOG2E;

constexpr size_t MiB = 1u << 20;
constexpr size_t WS_MOD = 0;
constexpr size_t WS_ROPE = 1 * MiB;
constexpr size_t WS_LAM = 1 * MiB + 16384;
constexpr size_t WS_BAR = 1 * MiB + 32768;
constexpr size_t WS_W = 2 * MiB;
constexpr size_t W_IN = 0, W_BR = W_IN + (size_t)INW * DM * 2, W_OUT = W_BR + (size_t)3 * DM * 512 * 2, W_GU = W_OUT + (size_t)DM * DM * 2,
                 W_DN = W_GU + (size_t)2 * DFF * DM * 2, W_END = W_DN + (size_t)DM * DFF * 2;
static_assert(W_END <= 34 * MiB, "weights region");
constexpr size_t WS_CTX = 36 * MiB;
constexpr size_t WS_H = 44 * MiB;
constexpr size_t WS_R = 112 * MiB;
constexpr size_t R_P = 0, R_Y = 216 * MiB;
constexpr size_t R_A = 0, R_UP = (size_t)MTOT * DFF * 2;
constexpr size_t WS_END = WS_R + 374 * MiB;
static_assert((size_t)MH * LDP * 2 <= 216 * MiB && R_Y + (size_t)MTOT * DM * 2 <= 374 * MiB && 2 * (size_t)MTOT * DFF * 2 <= 374 * MiB, "R region");

constexpr int LDS_BYTES = 131072 + 256;
constexpr int LDS_MISC = 131072;

struct Params {
  const float *x, *c, *ctx, *c_ctx, *w_ada, *b_ada, *norm1_g, *w_in, *sgu_ln_g, *sgu_ln_b, *w_s, *b_s, *lam_q1, *lam_k1, *lam_q2, *lam_k2,
      *diff_subln_g, *sinks, *w_branch, *w_out, *norm2_g, *w_gate, *conv_w, *conv_b, *w_up, *w_down, *final_g;
  float* out; unsigned char* ws;
};

DI unsigned cvtpk(float lo, float hi) { f32x2_t v = {lo, hi}; bf16x2_t b = __builtin_convertvector(v, bf16x2_t); return __builtin_bit_cast(unsigned, b); }
DI float bf_lo(unsigned w) { return __uint_as_float(w << 16); }
DI float bf_hi(unsigned w) { return __uint_as_float(w & 0xffff0000u); }
DI float ex2(float v) { return __builtin_amdgcn_exp2f(v); }
DI float fast_rcp(float v) { return __builtin_amdgcn_rcpf(v); }
DI float sigmoidf_(float v) { return fast_rcp(1.0f + ex2(-v * LOG2E)); }
DI float gelu_tanh(float v) { const float u = 0.7978845608028654f * (v + 0.044715f * v * v * v); return v * fast_rcp(1.0f + ex2(-2.0f * LOG2E * u)); }
DI float siluf_(float v) { return v * sigmoidf_(v); }
DI int opaque_tid() { int t = threadIdx.x; asm volatile("" : "+v"(t)); return t; }
DI float wave_sum(float v) {
#pragma unroll
  for (int o = 1; o < 64; o <<= 1) v += __shfl_xor(v, o);
  return v;
}
DI f32x4 mfma16(bf16x8 a, bf16x8 b, f32x4 c) { return __builtin_amdgcn_mfma_f32_16x16x32_bf16(a, b, c, 0, 0, 0); }
DI f32x16 mfma32(bf16x8 a, bf16x8 b, f32x16 c) { return __builtin_amdgcn_mfma_f32_32x32x16_bf16(a, b, c, 0, 0, 0); }
DI s16x4 tr_read(const char* p) { return __builtin_bit_cast(s16x4, __builtin_amdgcn_ds_read_tr16_b64_v4i16((__attribute__((address_space(3))) v4i16_t*)(uintptr_t)p)); }

template <int WNT>
DI void gemm_core(f32x4 (&acc)[8][WNT], const bf16_t* __restrict__ A, int lda, const bf16_t* __restrict__ B, int ldb, int K, char* lds) {
  const int tid = opaque_tid(), lane = tid & 63, wave = tid >> 6;
  const int wm = wave >> 2, wn = wave & 3, r16 = lane & 15, quad = lane >> 4;
  constexpr int BROWS = 64 * WNT;
  constexpr int STAGE = 16384 + BROWS * 64;
  const int srow = tid >> 2, skq = tid & 3;
  const int soff = srow * 64 + ((skq ^ ((4 - ((srow >> 2) & 3)) & 3)) * 16);
  const bf16_t* ga0 = A + (size_t)srow * lda + skq * 8;
  const bf16_t* ga1 = A + (size_t)(srow + 128) * lda + skq * 8;
  const bf16_t* gb0 = B + (size_t)srow * ldb + skq * 8;
  const bf16_t* gb1 = B + (size_t)(srow + 128) * ldb + skq * 8;
  const int rsw = ((quad ^ ((4 - ((r16 >> 2) & 3)) & 3)) * 16);
  const int aoff = (wm * 128 + r16) * 64 + rsw;
  const int boff = 16384 + (wn * 16 * WNT + r16) * 64 + rsw;
  u32x4 ra0, ra1, rb0, rb1;
  ra0 = *(const u32x4*)ga0; ra1 = *(const u32x4*)ga1;
  rb0 = *(const u32x4*)gb0; rb1 = rb0;
  if (WNT == 4) rb1 = *(const u32x4*)gb1;
  *(u32x4*)(lds + soff) = ra0; *(u32x4*)(lds + soff + 128 * 64) = ra1;
  if (WNT == 4) { *(u32x4*)(lds + 16384 + soff) = rb0; *(u32x4*)(lds + 16384 + soff + 128 * 64) = rb1; }
  else { *(u32x4*)(lds + 16384 + soff) = rb0; }
  __syncthreads();
  const int nk = K >> 5;
  for (int kt = 0; kt < nk; ++kt) {
    char* cur = lds + (kt & 1) * STAGE;
    char* nxt = lds + ((kt + 1) & 1) * STAGE;
    const bool more = (kt + 1) < nk;
    if (more) {
      const int ko = (kt + 1) * 32;
      ra0 = *(const u32x4*)(ga0 + ko); ra1 = *(const u32x4*)(ga1 + ko);
      rb0 = *(const u32x4*)(gb0 + ko);
      if (WNT == 4) rb1 = *(const u32x4*)(gb1 + ko);
    }
    bf16x8 af[8], bfr[WNT];
#pragma unroll
    for (int mt = 0; mt < 8; ++mt) af[mt] = *(const bf16x8*)(cur + aoff + mt * 1024);
#pragma unroll
    for (int nt = 0; nt < WNT; ++nt) bfr[nt] = *(const bf16x8*)(cur + boff + nt * 1024);
#pragma unroll
    for (int mt = 0; mt < 8; ++mt)
#pragma unroll
      for (int nt = 0; nt < WNT; ++nt) acc[mt][nt] = mfma16(bfr[nt], af[mt], acc[mt][nt]);
    if (more) {
      *(u32x4*)(nxt + soff) = ra0; *(u32x4*)(nxt + soff + 128 * 64) = ra1;
      *(u32x4*)(nxt + 16384 + soff) = rb0;
      if (WNT == 4) *(u32x4*)(nxt + 16384 + soff + 128 * 64) = rb1;
    }
    __syncthreads();
  }
}

template <int WNT>
DI void zero_acc(f32x4 (&acc)[8][WNT]) {
#pragma unroll
  for (int mt = 0; mt < 8; ++mt)
#pragma unroll
    for (int nt = 0; nt < WNT; ++nt) acc[mt][nt] = (f32x4){0.f, 0.f, 0.f, 0.f};
}

DI void transpose_item(const float* __restrict__ W, int K, int N, bf16_t* __restrict__ WT, int row_off, float* scr, int item, int lane, bool rope_perm = false) {
  const int nblk = N / 32, kb = item / nblk, nb = item % nblk, k0 = 64 * kb, n0 = 32 * nb;
#pragma unroll 8
  for (int i = 0; i < 32; ++i) { const int kk = 2 * i + (lane >> 5); scr[kk * 33 + (lane & 31)] = W[(size_t)(k0 + kk) * N + n0 + (lane & 31)]; }
  asm volatile("s_waitcnt lgkmcnt(0)" ::: "memory");
  const int c = lane & 7;
#pragma unroll
  for (int j = 0; j < 4; ++j) {
    const int n = (lane >> 3) + 8 * j; const float* s = scr + (8 * c) * 33 + n;
    u32x4 o; o.x = cvtpk(s[0 * 33], s[1 * 33]); o.y = cvtpk(s[2 * 33], s[3 * 33]); o.z = cvtpk(s[4 * 33], s[5 * 33]); o.w = cvtpk(s[6 * 33], s[7 * 33]);
    const int nn = rope_perm ? ((n < 16) ? 8 * (n >> 2) + (n & 3) : 8 * ((n - 16) >> 2) + 4 + (n & 3)) : n;
    *(u32x4*)(WT + (size_t)(row_off + n0 + nn) * K + k0 + 8 * c) = o;
  }
  asm volatile("s_waitcnt lgkmcnt(0)" ::: "memory");
}

DI void convert_weights(const Params& p, int l, char* lds, int vcu, int G) {
  const int tid = opaque_tid(), lane = tid & 63, wave = tid >> 6, gw = vcu * 8 + wave, ngw = G * 8;
  float* scr = (float*)(lds + wave * 8704);
  unsigned char* wsw = p.ws + WS_W;
  constexpr int I_IN = (DM / 64) * (INW / 32), I_BR = (512 / 64) * (DM / 32), I_OUT = (DM / 64) * (DM / 32), I_G = (DM / 64) * (DFF / 32), I_D = (DFF / 64) * (DM / 32);
  constexpr int NITEMS = I_IN + 3 * I_BR + I_OUT + 2 * I_G + I_D;
  for (int it = gw; it < NITEMS; it += ngw) {
    int r = it;
    if (r < I_IN) { const int c0 = 32 * (r % (INW / 32)); const bool rp = (c0 >= COL_BQ && c0 < COL_BV) || (c0 >= COL_CQ && c0 < COL_CV);
      transpose_item(p.w_in + (size_t)l * DM * INW, DM, INW, (bf16_t*)(wsw + W_IN), 0, scr, r, lane, rp); continue; } r -= I_IN;
    if (r < 3 * I_BR) { const int i = r / I_BR; transpose_item(p.w_branch + ((size_t)l * 3 + i) * 512 * DM, 512, DM, (bf16_t*)(wsw + W_BR) + (size_t)i * DM * 512, 0, scr, r % I_BR, lane); continue; } r -= 3 * I_BR;
    if (r < I_OUT) { transpose_item(p.w_out + (size_t)l * DM * DM, DM, DM, (bf16_t*)(wsw + W_OUT), 0, scr, r, lane); continue; } r -= I_OUT;
    if (r < I_G) { transpose_item(p.w_gate + (size_t)l * DM * DFF, DM, DFF, (bf16_t*)(wsw + W_GU), 0, scr, r, lane); continue; } r -= I_G;
    if (r < I_G) { transpose_item(p.w_up + (size_t)l * DM * DFF, DM, DFF, (bf16_t*)(wsw + W_GU), DFF, scr, r, lane); continue; } r -= I_G;
    transpose_item(p.w_down + (size_t)l * DFF * DM, DFF, DM, (bf16_t*)(wsw + W_DN), 0, scr, r, lane);
  }
}

DI void ada_phase(const Params& p, char* lds, int vcu, int G) {
  const int tid = opaque_tid();
  float* sv = (float*)lds;
  float* red = (float*)(lds + 9 * 1024 * 4);
  float* mod = (float*)(p.ws + WS_MOD);
  bool have = false;
  for (int u = vcu; u < DEPTH * 48; u += G) {
    if (!have) {
      for (int e = tid; e < 9 * 1024; e += 512) { const int i = e >> 10, k = e & 1023; const float v = (i < 8) ? p.c[i * 1024 + k] : p.c_ctx[k]; sv[e] = v / (1.0f + __expf(-v)); }
      have = true;
    }
    __syncthreads();
    const int l = u / 48, nb = u % 48, col = tid & 127, kg = tid >> 7;
    const float* w = p.w_ada + (size_t)l * DM * 6144 + nb * 128 + col;
    float a[9];
#pragma unroll
    for (int i = 0; i < 9; ++i) a[i] = 0.f;
#pragma unroll 8
    for (int k = kg * 256; k < kg * 256 + 256; ++k) {
      const float wv = w[(size_t)k * 6144];
#pragma unroll
      for (int i = 0; i < 9; ++i) a[i] += sv[i * 1024 + k] * wv;
    }
#pragma unroll
    for (int i = 0; i < 9; ++i) red[(kg * 9 + i) * 128 + col] = a[i];
    __syncthreads();
    for (int e = tid; e < 9 * 128; e += 512) {
      const int i = e >> 7, cc = e & 127;
      const float s = red[(0 * 9 + i) * 128 + cc] + red[(1 * 9 + i) * 128 + cc] + red[(2 * 9 + i) * 128 + cc] + red[(3 * 9 + i) * 128 + cc];
      mod[((size_t)l * 9 + i) * 6144 + nb * 128 + cc] = s + p.b_ada[l * 6144 + nb * 128 + cc];
    }
    __syncthreads();
  }
  __syncthreads();
}

DI void norm_phase(const Params& p, int l, int which, const float* lat_src, const float* ctx_src, int vcu, int G, int nrows) {
  const int tid = opaque_tid(), lane = tid & 63, gw = vcu * 8 + (tid >> 6), ngw = G * 8;
  bf16_t* H = (bf16_t*)(p.ws + WS_H);
  const float* mod = (const float*)(p.ws + WS_MOD);
  const float* g = (which ? p.norm2_g : p.norm1_g) + l * DM;
  f32x4 nv[4];
  if (gw < nrows) {
    const float* xr0 = (gw < NLAT) ? lat_src + (size_t)gw * DM : ctx_src + (size_t)(gw - NLAT) * DM;
#pragma unroll
    for (int j = 0; j < 4; ++j) nv[j] = ((const f32x4*)xr0)[lane + 64 * j];
  }
  for (int row = gw; row < nrows; row += ngw) {
    const int mi = (row < NLAT) ? (row >> 12) : 8;
    const float* sh = mod + ((size_t)(l * 9 + mi) * 6 + (which ? 3 : 0)) * DM;
    const float* sc = sh + DM;
    f32x4 v[4]; float ss = 0.f;
#pragma unroll
    for (int j = 0; j < 4; ++j) v[j] = nv[j];
    const int nr = row + ngw;
    if (nr < nrows) {
      const float* xn = (nr < NLAT) ? lat_src + (size_t)nr * DM : ctx_src + (size_t)(nr - NLAT) * DM;
#pragma unroll
      for (int j = 0; j < 4; ++j) nv[j] = ((const f32x4*)xn)[lane + 64 * j];
    }
#pragma unroll
    for (int j = 0; j < 4; ++j) ss += (v[j].x * v[j].x + v[j].y * v[j].y) + (v[j].z * v[j].z + v[j].w * v[j].w);
    const float rstd = 1.0f / sqrtf(wave_sum(ss) * (1.0f / DM) + EPS);
    u32x2* o = (u32x2*)(H + (size_t)row * DM);
#pragma unroll
    for (int j = 0; j < 4; ++j) {
      const f32x4 gg = ((const f32x4*)g)[lane + 64 * j], s1 = ((const f32x4*)sc)[lane + 64 * j], s0 = ((const f32x4*)sh)[lane + 64 * j];
      const f32x4 y = (v[j] * rstd * gg) * (s1 + 1.0f) + s0;
      u32x2 w; w.x = cvtpk(y.x, y.y); w.y = cvtpk(y.z, y.w);
      o[lane + 64 * j] = w;
    }
  }
}

DI int half_grow(int hb, int lrow) { return (lrow < HALF_LAT) ? hb * HALF_LAT + lrow : NLAT + hb * HALF_CTX + (lrow - HALF_LAT); }

DI void gemm1_phase(const Params& p, int hb, char* lds, int vcu, int G) {
  const int tid = opaque_tid(), lane = tid & 63, wave = tid >> 6, wm = wave >> 2, wn = wave & 3, r16 = lane & 15, quad = lane >> 4;
  const bf16_t* H = (const bf16_t*)(p.ws + WS_H);
  const bf16_t* Wt = (const bf16_t*)(p.ws + WS_W + W_IN);
  bf16_t* P = (bf16_t*)(p.ws + WS_R + R_P);
  const float* ropec = (const float*)(p.ws + WS_ROPE);
  const float* ropes = ropec + 1024;
  constexpr int NT = INW / 256, MT = MH / 256;
  for (int u = vcu; u < MT * NT; u += G) {
    const int tm = u / NT, tn = u % NT;
    const int lrow0 = tm * 256, grow0 = half_grow(hb, lrow0), n0 = tn * 256;
    f32x4 acc[8][4]; zero_acc<4>(acc);
    gemm_core<4>(acc, H + (size_t)grow0 * DM, DM, Wt + (size_t)n0 * DM, DM, DM, lds);
    const int cb = n0 + wn * 64;
    const bool latent = lrow0 < HALF_LAT;
    int kind = 0;
    if (cb < COL_BQ) kind = 1;
    else if (cb < COL_BV || (cb >= COL_CQ && cb < COL_CV)) kind = latent ? 2 : 0;
    else if (cb >= COL_G) kind = 3;
    const bool qscale = (cb >= COL_BQ && cb < COL_BK) || (cb >= COL_CQ && cb < COL_CK);
#pragma unroll
    for (int mt = 0; mt < 8; ++mt) {
      const int lr = lrow0 + wm * 128 + mt * 16 + r16;
      if (kind == 1) {
#pragma unroll
        for (int nt = 0; nt < 4; ++nt)
#pragma unroll
          for (int j = 0; j < 4; ++j) acc[mt][nt][j] = gelu_tanh(acc[mt][nt][j]);
      } else if (kind == 3) {
#pragma unroll
        for (int nt = 0; nt < 4; ++nt)
#pragma unroll
          for (int j = 0; j < 4; ++j) acc[mt][nt][j] = sigmoidf_(acc[mt][nt][j]);
      } else if (kind == 2) {
        const int t = lr & (SEQ - 1);
        const int pr = t >> 6, pc = t & 63;
        const f32x4 cr = *(const f32x4*)(ropec + pr * 16 + quad * 4), sr = *(const f32x4*)(ropes + pr * 16 + quad * 4);
        const f32x4 cc = *(const f32x4*)(ropec + pc * 16 + quad * 4), sc = *(const f32x4*)(ropes + pc * 16 + quad * 4);
        const f32x4 a1 = acc[mt][0], a2 = acc[mt][1], b1 = acc[mt][2], b2 = acc[mt][3];
        acc[mt][0] = a1 * cr - a2 * sr; acc[mt][1] = a2 * cr + a1 * sr;
        acc[mt][2] = b1 * cc - b2 * sc; acc[mt][3] = b2 * cc + b1 * sc;
      }
      if (qscale) {
#pragma unroll
        for (int nt = 0; nt < 4; ++nt) acc[mt][nt] = acc[mt][nt] * SM_C;
      }
      bf16_t* orow = P + (size_t)lr * LDP + cb + quad * 4;
#pragma unroll
      for (int nt = 0; nt < 4; ++nt) { u32x2 w; w.x = cvtpk(acc[mt][nt][0], acc[mt][nt][1]); w.y = cvtpk(acc[mt][nt][2], acc[mt][nt][3]); *(u32x2*)(orow + nt * 16) = w; }
    }
  }
}

DI void merge_phase(const Params& p, int hb, char* lds, int vcu, int G, int mtiles) {
  const int tid = opaque_tid(), lane = tid & 63, wave = tid >> 6, wm = wave >> 2, wn = wave & 3, r16 = lane & 15, quad = lane >> 4;
  const bf16_t* P = (const bf16_t*)(p.ws + WS_R + R_P);
  const bf16_t* Wb = (const bf16_t*)(p.ws + WS_W + W_BR);
  bf16_t* Y = (bf16_t*)(p.ws + WS_R + R_Y);
  constexpr int NT = DM / 128;
  for (int u = vcu; u < mtiles * NT; u += G) {
    const int tm = u / NT, tn = u % NT;
    const int lrow0 = tm * 256, grow0 = half_grow(hb, lrow0), n0 = tn * 128;
    f32x4 y[8][2]; zero_acc<2>(y);
#pragma unroll 1
    for (int i = 0; i < 3; ++i) {
      const int ocol = (i == 0) ? COL_AU : (i == 1 ? COL_BQ : COL_CQ);
      f32x4 acc[8][2]; zero_acc<2>(acc);
      gemm_core<2>(acc, P + (size_t)lrow0 * LDP + ocol, LDP, Wb + ((size_t)i * DM + n0) * 512, 512, 512, lds);
#pragma unroll
      for (int mt = 0; mt < 8; ++mt) {
        const int lr = lrow0 + wm * 128 + mt * 16 + r16;
        const bf16_t* gp = P + (size_t)lr * LDP + COL_G + i * DM + n0 + wn * 32 + quad * 4;
#pragma unroll
        for (int nt = 0; nt < 2; ++nt) {
          const u32x2 gw = *(const u32x2*)(gp + nt * 16);
          y[mt][nt][0] += bf_lo(gw.x) * acc[mt][nt][0]; y[mt][nt][1] += bf_hi(gw.x) * acc[mt][nt][1];
          y[mt][nt][2] += bf_lo(gw.y) * acc[mt][nt][2]; y[mt][nt][3] += bf_hi(gw.y) * acc[mt][nt][3];
        }
      }
    }
#pragma unroll
    for (int mt = 0; mt < 8; ++mt) {
      const int gr = grow0 + wm * 128 + mt * 16 + r16;
      bf16_t* orow = Y + (size_t)gr * DM + n0 + wn * 32 + quad * 4;
#pragma unroll
      for (int nt = 0; nt < 2; ++nt) { u32x2 w; w.x = cvtpk(y[mt][nt][0], y[mt][nt][1]); w.y = cvtpk(y[mt][nt][2], y[mt][nt][3]); *(u32x2*)(orow + nt * 16) = w; }
    }
  }
}

DI void resid_gemm_phase(const Params& p, int l, const bf16_t* A, int lda, const bf16_t* Wt, int K, int gidx,
                         const float* lat_src, const float* ctx_src, float* lat_dst, float* ctx_dst, char* lds, int vcu, int G) {
  const int tid = opaque_tid(), lane = tid & 63, wave = tid >> 6, wm = wave >> 2, wn = wave & 3, r16 = lane & 15, quad = lane >> 4;
  const float* mod = (const float*)(p.ws + WS_MOD);
  constexpr int NT = DM / 256, MT = MTOT / 256;
  for (int u = vcu; u < MT * NT; u += G) {
    const int tm = u / NT, tn = u % NT;
    const int grow0 = tm * 256, n0 = tn * 256;
    f32x4 acc[8][4]; zero_acc<4>(acc);
    gemm_core<4>(acc, A + (size_t)grow0 * lda, lda, Wt + (size_t)n0 * K, K, K, lds);
    const bool latent = grow0 < NLAT;
    const int mi = latent ? (grow0 >> 12) : 8;
    const float* gv = mod + ((size_t)(l * 9 + mi) * 6 + gidx) * DM + n0 + wn * 64 + quad * 4;
    f32x4 gg[4];
#pragma unroll
    for (int nt = 0; nt < 4; ++nt) gg[nt] = *(const f32x4*)(gv + nt * 16);
#pragma unroll
    for (int mt = 0; mt < 8; ++mt) {
      const int gr = grow0 + wm * 128 + mt * 16 + r16;
      const size_t off = (latent ? (size_t)gr * DM : (size_t)(gr - NLAT) * DM) + n0 + wn * 64 + quad * 4;
      const float* src = (latent ? lat_src : ctx_src) + off;
      float* dst = (latent ? lat_dst : ctx_dst) + off;
#pragma unroll
      for (int nt = 0; nt < 4; ++nt) { const f32x4 r = *(const f32x4*)(src + nt * 16); *(f32x4*)(dst + nt * 16) = r + gg[nt] * acc[mt][nt]; }
    }
  }
}

DI void gateup_phase(const Params& p, char* lds, int vcu, int G) {
  const int tid = opaque_tid(), lane = tid & 63, wave = tid >> 6, wm = wave >> 2, wn = wave & 3, r16 = lane & 15, quad = lane >> 4;
  const bf16_t* H = (const bf16_t*)(p.ws + WS_H);
  const bf16_t* Wt = (const bf16_t*)(p.ws + WS_W + W_GU);
  bf16_t* Ab = (bf16_t*)(p.ws + WS_R + R_A);
  bf16_t* Ub = (bf16_t*)(p.ws + WS_R + R_UP);
  constexpr int NT = 2 * DFF / 256, MT = MTOT / 256;
  for (int u = vcu; u < MT * NT; u += G) {
    const int tm = u / NT, tn = u % NT;
    const int grow0 = tm * 256, n0 = tn * 256;
    f32x4 acc[8][4]; zero_acc<4>(acc);
    gemm_core<4>(acc, H + (size_t)grow0 * DM, DM, Wt + (size_t)n0 * DM, DM, DM, lds);
    bf16_t* O = (n0 < DFF) ? Ab + n0 : Ub + (n0 - DFF);
#pragma unroll
    for (int mt = 0; mt < 8; ++mt) {
      const int gr = grow0 + wm * 128 + mt * 16 + r16;
      bf16_t* orow = O + (size_t)gr * DFF + wn * 64 + quad * 4;
#pragma unroll
      for (int nt = 0; nt < 4; ++nt) { u32x2 w; w.x = cvtpk(acc[mt][nt][0], acc[mt][nt][1]); w.y = cvtpk(acc[mt][nt][2], acc[mt][nt][3]); *(u32x2*)(orow + nt * 16) = w; }
    }
  }
}

DI void conv_phase(const Params& p, int l, int vcu, int G, int nrows) {
  const int tid = opaque_tid();
  const bf16_t* Ab = (const bf16_t*)(p.ws + WS_R + R_A);
  bf16_t* Ub = (bf16_t*)(p.ws + WS_R + R_UP);
  if (tid >= DFF / 8) return;
  const int cc = tid * 8;
  const float* cw = p.conv_w + (size_t)l * 3 * DFF + cc;
  const float* cb = p.conv_b + (size_t)l * DFF + cc;
  float w0[8], w1[8], w2[8], bb[8];
#pragma unroll
  for (int j = 0; j < 2; ++j) {
    const f32x4 a = *(const f32x4*)(cw + 4 * j), b = *(const f32x4*)(cw + DFF + 4 * j), c = *(const f32x4*)(cw + 2 * DFF + 4 * j), d = *(const f32x4*)(cb + 4 * j);
#pragma unroll
    for (int i = 0; i < 4; ++i) { w0[4 * j + i] = a[i]; w1[4 * j + i] = b[i]; w2[4 * j + i] = c[i]; bb[4 * j + i] = d[i]; }
  }
  const int rpb = (nrows + G - 1) / G;
  const int r0 = vcu * rpb, r1 = (r0 + rpb < nrows) ? r0 + rpb : nrows;
  const u32x4 zero = {0u, 0u, 0u, 0u};
  auto seq_first = [](int row) -> bool { return row < NLAT ? (row & (SEQ - 1)) == 0 : ((row - NLAT) & (NCTX - 1)) == 0; };
  auto seq_last = [](int row) -> bool { return row < NLAT ? (row & (SEQ - 1)) == SEQ - 1 : ((row - NLAT) & (NCTX - 1)) == NCTX - 1; };
  if (r0 >= r1) return;
  u32x4 aprev = seq_first(r0) ? zero : *(const u32x4*)(Ab + (size_t)(r0 - 1) * DFF + cc);
  u32x4 acur = *(const u32x4*)(Ab + (size_t)r0 * DFF + cc);
  for (int row = r0; row < r1; row += 4) {
    u32x4 an[4], uu[4];
#pragma unroll
    for (int i = 0; i < 4; ++i) {
      const int rr = row + i;
      an[i] = zero; uu[i] = zero;
      if (rr < r1) {
        an[i] = *(const u32x4*)(Ab + (size_t)(rr + 1) * DFF + cc);
        uu[i] = *(const u32x4*)(Ub + (size_t)rr * DFF + cc);
      }
    }
#pragma unroll
    for (int i = 0; i < 4; ++i) {
      const int rr = row + i;
      if (rr < r1) {
        const u32x4 ap = seq_first(rr) ? zero : aprev;
        const u32x4 ax = seq_last(rr) ? zero : an[i];
        u32x4 o;
#pragma unroll
        for (int j = 0; j < 4; ++j) {
          const float v0 = w0[2 * j] * bf_lo(ap[j]) + w1[2 * j] * bf_lo(acur[j]) + w2[2 * j] * bf_lo(ax[j]) + bb[2 * j];
          const float v1 = w0[2 * j + 1] * bf_hi(ap[j]) + w1[2 * j + 1] * bf_hi(acur[j]) + w2[2 * j + 1] * bf_hi(ax[j]) + bb[2 * j + 1];
          o[j] = cvtpk(siluf_(v0) * bf_lo(uu[i][j]), siluf_(v1) * bf_hi(uu[i][j]));
        }
        *(u32x4*)(Ub + (size_t)rr * DFF + cc) = o;
        aprev = acur; acur = an[i];
      }
    }
  }
}

namespace pg8 {
#define PG8_LAS __attribute__((address_space(3)))
typedef unsigned short bf16_t;
typedef short bf16x8 __attribute__((ext_vector_type(8)));
typedef float f32x4 __attribute__((ext_vector_type(4)));
typedef unsigned u32x4 __attribute__((ext_vector_type(4)));
constexpr int BM = 256, BK = 64, HALF = 128, HTB = HALF * BK * 2  , STAGE_BYTES = 8 * HTB, NXCD = 8, WGM = 8;

__host__ __device__ __forceinline__ int lds_byte(int r, int c) { const int st = (r >> 4) * 2 + (c >> 5), rr = r & 15, cc = c & 31, ob = rr * 64 + cc * 2; return st * 1024 + (ob ^ (((ob >> 9) & 1) << 5)); }
__host__ __device__ __forceinline__ void stage_rc(int b, int& R, int& C) { const int st = b / 1024, sb = b % 1024, swz = sb ^ (((sb >> 9) & 1) << 5); R = (st >> 1) * 16 + swz / 64; C = (st & 1) * 32 + (swz % 64) / 2; }
__host__ __device__ __forceinline__ int perm32(int rho) { const int n = rho >> 4, i = rho & 15; return 8 * (i >> 2) + 4 * n + (i & 3); }

struct Unit { int pm, pn; const char* A; const char* B; int nt; int flags; };
struct Gemm { int lda, ldb; };
template <class Epi, class Sched, bool ALIGN_EPI = false, bool SP2 = false>
__device__ __forceinline__ void gemm_phase(PG8_LAS unsigned char* lds, const Gemm g, const Sched& S, const Epi& E) {
    const int tid = opaque_tid(), wid = __builtin_amdgcn_readfirstlane(tid >> 6), lane = tid & 63, wr = wid >> 2, wc = wid & 3, fr = lane & 15, fq = lane >> 4;
    const int lda = g.lda, ldb = g.ldb;
    unsigned voffA[2], voffB[2];
#pragma unroll
    for (int i = 0; i < 2; ++i) { int R, C; stage_rc(tid * 16 + i * 8192, R, C); const int Rb = Epi::PERM ? ((R & ~31) + perm32(R & 31)) : R;
        voffA[i] = (unsigned)(R * lda + C) * 2u; voffB[i] = (unsigned)(Rb * ldb + C) * 2u; }
    const size_t kstep = (size_t)(BK * 2);
    const size_t hstepA = (size_t)HALF * lda * 2, hstepB = (size_t)HALF * ldb * 2;
    const unsigned ldsw = (unsigned)wid * 1024u;
    const int aoff = lds_byte(wr * 64 + fr, fq * 8), boff = lds_byte(wc * 32 + fr, fq * 8);
#define PG8_SA(b, h) (((b) * 2 + (h)) * HTB)
#define PG8_SB(b, h) ((4 + (b) * 2 + (h)) * HTB)
#define PG8_STAGE(bufoff, gbase, voff) do { _Pragma("unroll") for (int _i = 0; _i < 2; ++_i) \
        __builtin_amdgcn_global_load_lds((const unsigned*)((const char*)(gbase) + (voff)[_i]), (PG8_LAS unsigned*)(lds + (bufoff) + ldsw + _i * 8192), 16, 0, 0); } while (0)
#define PG8_LDA(dst, b, h) do { _Pragma("unroll") for (int m = 0; m < 4; ++m) _Pragma("unroll") for (int k = 0; k < 2; ++k) dst[m][k] = *(const PG8_LAS bf16x8*)(lds + PG8_SA(b, h) + aoff + m * 2048 + k * 1024); } while (0)
#define PG8_LDB(dst, b, h) do { _Pragma("unroll") for (int n = 0; n < 2; ++n) _Pragma("unroll") for (int k = 0; k < 2; ++k) dst[n][k] = *(const PG8_LAS bf16x8*)(lds + PG8_SB(b, h) + boff + n * 2048 + k * 1024); } while (0)
#define PG8_MMA(ai, bj, At, Bt) do { __builtin_amdgcn_s_setprio(1); _Pragma("unroll") for (int m = 0; m < 4; ++m) _Pragma("unroll") for (int n = 0; n < 2; ++n) _Pragma("unroll") for (int k = 0; k < 2; ++k) \
        acc[ai][bj][m][n] = __builtin_amdgcn_mfma_f32_16x16x32_bf16(Bt[n][k], At[m][k], acc[ai][bj][m][n], 0, 0, 0); __builtin_amdgcn_s_setprio(0); } while (0)
#define PG8_WAIT_V(n) asm volatile("s_waitcnt vmcnt(" #n ")" ::: "memory")
#define PG8_WAIT_L(n) asm volatile("s_waitcnt lgkmcnt(" #n ")" ::: "memory")
#define PG8_BAR __builtin_amdgcn_s_barrier()
#define PG8_SCHED __builtin_amdgcn_sched_barrier(0)
    Unit cur, nxt; int ui = 0;
    if (!S.next(0, cur)) return;
    f32x4 acc[2][2][4][2];
#pragma unroll
    for (int a = 0; a < 2; ++a)
#pragma unroll
        for (int b = 0; b < 2; ++b)
#pragma unroll
            for (int m = 0; m < 4; ++m)
#pragma unroll
                for (int n = 0; n < 2; ++n) acc[a][b][m][n] = (f32x4){0.f, 0.f, 0.f, 0.f};
    bf16x8 At[4][2], B0[2][2], B1[2][2];
    const char* cA = cur.A; const char* cB = cur.B;
    S.a_ready(cur);
    if constexpr (SP2) {
        PG8_STAGE(PG8_SB(0, 0), cB, voffB); PG8_STAGE(PG8_SB(0, 1), cB + hstepB, voffB); PG8_STAGE(PG8_SA(0, 0), cA, voffA); PG8_STAGE(PG8_SA(0, 1), cA + hstepA, voffA);
        if (wr == 1) PG8_BAR;
        PG8_WAIT_V(2); PG8_BAR;
        PG8_STAGE(PG8_SB(1, 0), cB + kstep, voffB); PG8_STAGE(PG8_SA(1, 0), cA + kstep, voffA); PG8_STAGE(PG8_SB(1, 1), cB + hstepB + kstep, voffB);
        PG8_WAIT_V(6); PG8_BAR;
    } else {
        PG8_STAGE(PG8_SB(0, 0), cB, voffB); PG8_STAGE(PG8_SA(0, 0), cA, voffA); PG8_STAGE(PG8_SB(0, 1), cB + hstepB, voffB); PG8_STAGE(PG8_SA(0, 1), cA + hstepA, voffA);
        if (wr == 1) PG8_BAR;
        PG8_WAIT_V(4); PG8_BAR;
        PG8_STAGE(PG8_SB(1, 0), cB + kstep, voffB); PG8_STAGE(PG8_SA(1, 0), cA + kstep, voffA); PG8_STAGE(PG8_SB(1, 1), cB + hstepB + kstep, voffB);
        PG8_WAIT_V(6); PG8_BAR;
    }
    for (;;) {
        const bool has_next = S.next(ui + 1, nxt);
        const char* nA = has_next ? nxt.A : cA; const char* nB = has_next ? nxt.B : cB;
        const int nt = cur.nt;
        for (int t = 0; t < nt; t += 2) {
            const bool last = (t == nt - 2);
            const char* a1 = cA + (size_t)(t + 1) * kstep;
            const char* a2 = last ? nA : cA + (size_t)(t + 2) * kstep; const char* b2 = last ? nB : cB + (size_t)(t + 2) * kstep;
            const char* a3 = a2 + kstep; const char* b3 = b2 + kstep;
            if (last && has_next) S.a_ready(nxt);
            if constexpr (SP2) {
            PG8_LDB(B0, 0, 0); PG8_LDB(B1, 0, 1); PG8_SCHED; PG8_LDA(At, 0, 0); PG8_STAGE(PG8_SA(1, 1), a1 + hstepA, voffA);
            PG8_WAIT_V(8); PG8_WAIT_L(0); PG8_BAR; PG8_MMA(0, 0, At, B0); PG8_MMA(0, 1, At, B1); PG8_BAR; PG8_SCHED;
            PG8_LDA(At, 0, 1); PG8_STAGE(PG8_SB(0, 0), b2, voffB); PG8_STAGE(PG8_SB(0, 1), b2 + hstepB, voffB); PG8_STAGE(PG8_SA(0, 0), a2, voffA);
            PG8_WAIT_V(8); PG8_WAIT_L(0); PG8_BAR; PG8_MMA(1, 0, At, B0); PG8_MMA(1, 1, At, B1); PG8_BAR; PG8_SCHED;
            PG8_LDB(B0, 1, 0); PG8_LDB(B1, 1, 1); PG8_SCHED; PG8_LDA(At, 1, 0); PG8_STAGE(PG8_SA(0, 1), a2 + hstepA, voffA);
            PG8_WAIT_V(8); PG8_WAIT_L(0); PG8_BAR; PG8_MMA(0, 0, At, B0); PG8_MMA(0, 1, At, B1); PG8_BAR; PG8_SCHED;
            PG8_LDA(At, 1, 1); PG8_STAGE(PG8_SB(1, 0), b3, voffB); PG8_STAGE(PG8_SB(1, 1), b3 + hstepB, voffB); PG8_STAGE(PG8_SA(1, 0), a3, voffA);
            PG8_WAIT_V(8); PG8_WAIT_L(0); PG8_BAR; PG8_MMA(1, 0, At, B0); PG8_MMA(1, 1, At, B1); PG8_BAR; PG8_SCHED;
            } else {
            PG8_LDB(B0, 0, 0); PG8_SCHED; PG8_LDA(At, 0, 0); PG8_STAGE(PG8_SA(1, 1), a1 + hstepA, voffA);
            PG8_WAIT_L(8); PG8_BAR; PG8_WAIT_L(0); PG8_MMA(0, 0, At, B0); PG8_BAR; PG8_SCHED;
            PG8_LDB(B1, 0, 1); PG8_STAGE(PG8_SB(0, 0), b2, voffB);
            PG8_BAR; PG8_WAIT_L(0); PG8_MMA(0, 1, At, B1); PG8_BAR;
            PG8_LDA(At, 0, 1); PG8_STAGE(PG8_SA(0, 0), a2, voffA);
            PG8_BAR; PG8_WAIT_L(0); PG8_MMA(1, 0, At, B0); PG8_BAR; PG8_SCHED;
            PG8_STAGE(PG8_SB(0, 1), b2 + hstepB, voffB);
            PG8_WAIT_V(6); PG8_BAR; PG8_MMA(1, 1, At, B1); PG8_BAR;
            PG8_LDB(B0, 1, 0); PG8_SCHED; PG8_LDA(At, 1, 0); PG8_STAGE(PG8_SA(0, 1), a2 + hstepA, voffA);
            PG8_WAIT_L(8); PG8_BAR; PG8_WAIT_L(0); PG8_MMA(0, 0, At, B0); PG8_BAR; PG8_SCHED;
            PG8_LDB(B1, 1, 1); PG8_STAGE(PG8_SB(1, 0), b3, voffB);
            PG8_BAR; PG8_WAIT_L(0); PG8_MMA(0, 1, At, B1); PG8_BAR;
            PG8_LDA(At, 1, 1); PG8_STAGE(PG8_SA(1, 0), a3, voffA);
            PG8_BAR; PG8_WAIT_L(0); PG8_MMA(1, 0, At, B0); PG8_BAR; PG8_SCHED;
            PG8_STAGE(PG8_SB(1, 1), b3 + hstepB, voffB);
            PG8_WAIT_V(6); PG8_BAR; PG8_MMA(1, 1, At, B1); PG8_BAR;
            }
        }
        if constexpr (ALIGN_EPI) { if (wr == 0) PG8_BAR; }
        if constexpr (!Epi::AFTER_DRAIN) { E(acc, cur, wr, wc, fr, fq); S.done(cur); }
        if (!has_next) break;
        if (!(cur.flags & 1))
#pragma unroll
        for (int a = 0; a < 2; ++a)
#pragma unroll
            for (int b = 0; b < 2; ++b)
#pragma unroll
                for (int m = 0; m < 4; ++m)
#pragma unroll
                    for (int n = 0; n < 2; ++n) acc[a][b][m][n] = (f32x4){0.f, 0.f, 0.f, 0.f};
        cur = nxt; cA = nA; cB = nB; ++ui;
        if constexpr (ALIGN_EPI) { if (wr == 1) PG8_BAR; }
    }
    PG8_WAIT_V(0);
    if constexpr (!ALIGN_EPI) { if (wr == 0) PG8_BAR; }
    PG8_BAR;
    if constexpr (Epi::AFTER_DRAIN) { E.fused(acc, cur, wr, wc, fr, fq, lds, wid, lane); S.done(cur); }
#undef PG8_SA
#undef PG8_SB
#undef PG8_STAGE
#undef PG8_LDA
#undef PG8_LDB
#undef PG8_MMA
#undef PG8_WAIT_V
#undef PG8_WAIT_L
#undef PG8_BAR
#undef PG8_SCHED
}
}
namespace pg8 {
struct TileOrder {
  const char* A; const char* B; size_t tstepA, tstepB; int ntK;
  int nN, ntiles, G, c, hb;
  __device__ __forceinline__ bool next(int i, Unit& u) const {
    const int L = i * G + c; if (L >= ntiles) return false;
    const int gsz = 4 * nN, gi = L / gsz, w = L - gi * gsz;
    const int lt = gi * 4 + (w & 3); u.pn = w >> 2;
    u.pm = (hb < 0) ? lt : ((lt < 64) ? hb * 64 + lt : 128 + hb * 4 + (lt - 64));
    u.A = A + (size_t)u.pm * tstepA; u.B = B + (size_t)u.pn * tstepB; u.nt = ntK; u.flags = 0;
    return true;
  }
  __device__ __forceinline__ void a_ready(const Unit&) const {}
  __device__ __forceinline__ void done(const Unit&) const {}
};
struct ResidOrder {
  const char* A; const char* B; size_t tstepA, tstepB; int ntK;
  int nunits, G, c;
  __device__ __forceinline__ bool next(int i, Unit& u) const {
    const int L = i * G + c; if (L >= nunits) return false;
    int k0 = 0;
    if (L < 512) { u.pm = L >> 2; u.pn = L & 3; }
    else { const int tile = L - 512; u.pm = 128 + (tile >> 2); u.pn = tile & 3; }
    u.nt = ntK; u.flags = 0;
    u.A = A + (size_t)u.pm * tstepA + (size_t)k0 * (BK * 2); u.B = B + (size_t)u.pn * tstepB + (size_t)k0 * (BK * 2);
    return true;
  }
  __device__ __forceinline__ void a_ready(const Unit&) const {}
  __device__ __forceinline__ void done(const Unit&) const {}
};
struct MergeOrder {
  const char* P; const char* Wb; int ntiles, G, c;
  __device__ __forceinline__ bool next(int i, Unit& u) const {
    const int rnd = i / 3, br = i - 3 * rnd;
    const int T = rnd * G + c; if (T >= ntiles) return false;
    const int lt = (T < 256) ? (T >> 2) : 64 + ((T - 256) >> 2);
    u.pm = lt; u.pn = T & 3;
    const int ocol = (br == 0) ? COL_AU : (br == 1 ? COL_BQ : COL_CQ);
    u.A = P + ((size_t)lt * 256 * LDP + ocol) * 2; u.B = Wb + ((size_t)br * DM + u.pn * 256) * 512 * 2;
    u.nt = 512 / BK; u.flags = (br < 2 ? 1 : 0) | (br << 4);
    return true;
  }
  __device__ __forceinline__ void a_ready(const Unit&) const {}
  __device__ __forceinline__ void done(const Unit&) const {}
};
struct EpiMerge {
  static constexpr bool PERM = true, AFTER_DRAIN = false;
  const ::bf16_t* P; ::bf16_t* Y; int hb;
  __device__ __forceinline__ void operator()(f32x4 (&acc)[2][2][4][2], const Unit& u, int wr, int wc, int fr, int fq) const {
    const int br = u.flags >> 4;
#pragma unroll
    for (int ai = 0; ai < 2; ++ai)
#pragma unroll
      for (int m = 0; m < 4; ++m) {
        const int lr = u.pm * 256 + ai * 128 + wr * 64 + m * 16 + fr;
        const ::bf16_t* gp = P + (size_t)lr * LDP + COL_G + br * DM + u.pn * 256 + wc * 32 + 8 * fq;
#pragma unroll
        for (int bj = 0; bj < 2; ++bj) {
          const u32x4 gi = *(const u32x4*)(gp + bj * 128);
          float sc[8];
#pragma unroll
          for (int k = 0; k < 4; ++k) { sc[2 * k] = bf_lo(gi[k]); sc[2 * k + 1] = bf_hi(gi[k]); }
          if (br < 2) {
            const u32x4 gn = *(const u32x4*)(gp + DM + bj * 128);
#pragma unroll
            for (int k = 0; k < 4; ++k) { sc[2 * k] *= fast_rcp(fmaxf(bf_lo(gn[k]), 1e-30f)); sc[2 * k + 1] *= fast_rcp(fmaxf(bf_hi(gn[k]), 1e-30f)); }
          }
          f32x4 v0 = acc[ai][bj][m][0], v1 = acc[ai][bj][m][1];
          v0[0] *= sc[0]; v0[1] *= sc[1]; v0[2] *= sc[2]; v0[3] *= sc[3]; v1[0] *= sc[4]; v1[1] *= sc[5]; v1[2] *= sc[6]; v1[3] *= sc[7];
          acc[ai][bj][m][0] = v0; acc[ai][bj][m][1] = v1;
          if (br == 2) {
            const int gr = half_grow(hb, lr);
            u32x4 w; w.x = cvtpk(v0[0], v0[1]); w.y = cvtpk(v0[2], v0[3]); w.z = cvtpk(v1[0], v1[1]); w.w = cvtpk(v1[2], v1[3]);
            *(u32x4*)(Y + (size_t)gr * DM + u.pn * 256 + bj * 128 + wc * 32 + 8 * fq) = w;
          }
        }
      }
  }
};
struct EpiGemm1 {
  static constexpr bool PERM = true, AFTER_DRAIN = false;
  ::bf16_t* P; int hb; const float* ropec; const float* ropes;
  __device__ __forceinline__ void operator()(const f32x4 (&acc)[2][2][4][2], const Unit& u, int wr, int wc, int fr, int fq) const {
    const bool latent = u.pm < 128;
    const int lt = latent ? (u.pm - hb * 64) : (64 + (u.pm - 128 - hb * 4));
#pragma unroll
    for (int bj = 0; bj < 2; ++bj) {
      const int cb = u.pn * 256 + bj * 128 + wc * 32;
      int kind = 0;
      if (cb < COL_BQ) kind = 1;
      else if (cb < COL_BV || (cb >= COL_CQ && cb < COL_CV)) kind = latent ? 2 : 0;
      else if (cb >= COL_G) kind = 3;
      const bool qscale = (cb >= COL_BQ && cb < COL_BK) || (cb >= COL_CQ && cb < COL_CK);
      const bool colpart = (wc & 1) != 0;
#pragma unroll
      for (int ai = 0; ai < 2; ++ai)
#pragma unroll
        for (int m = 0; m < 4; ++m) {
          const int lr = lt * 256 + ai * 128 + wr * 64 + m * 16 + fr;
          f32x4 v0 = acc[ai][bj][m][0], v1 = acc[ai][bj][m][1];
          if (kind == 1) {
#pragma unroll
            for (int j = 0; j < 4; ++j) { v0[j] = gelu_tanh(v0[j]); v1[j] = gelu_tanh(v1[j]); }
          } else if (kind == 3) {
#pragma unroll
            for (int j = 0; j < 4; ++j) { v0[j] = sigmoidf_(v0[j]); v1[j] = sigmoidf_(v1[j]); }
          } else if (kind == 2) {
            const int t = lr & (SEQ - 1);
            const int pos = colpart ? (t & 63) : (t >> 6);
            const f32x4 c4 = *(const f32x4*)(ropec + pos * 16 + fq * 4), s4 = *(const f32x4*)(ropes + pos * 16 + fq * 4);
            const f32x4 a1 = v0, a2 = v1;
            v0 = a1 * c4 - a2 * s4; v1 = a2 * c4 + a1 * s4;
          }
          if (qscale) { v0 = v0 * SM_C; v1 = v1 * SM_C; }
          u32x4 w; w.x = cvtpk(v0[0], v0[1]); w.y = cvtpk(v0[2], v0[3]); w.z = cvtpk(v1[0], v1[1]); w.w = cvtpk(v1[2], v1[3]);
          *(u32x4*)(P + (size_t)lr * LDP + cb + fq * 8) = w;
        }
    }
  }
};
struct EpiGateUp {
  static constexpr bool PERM = true, AFTER_DRAIN = false;
  ::bf16_t* Ab; ::bf16_t* Ub;
  __device__ __forceinline__ void operator()(const f32x4 (&acc)[2][2][4][2], const Unit& u, int wr, int wc, int fr, int fq) const {
    const int n0 = u.pn * 256;
    ::bf16_t* O = (n0 < DFF) ? Ab + n0 : Ub + (n0 - DFF);
#pragma unroll
    for (int ai = 0; ai < 2; ++ai)
#pragma unroll
      for (int m = 0; m < 4; ++m) {
        const int gr = u.pm * 256 + ai * 128 + wr * 64 + m * 16 + fr;
        ::bf16_t* orow = O + (size_t)gr * DFF + wc * 32 + 8 * fq;
#pragma unroll
        for (int bj = 0; bj < 2; ++bj) {
          const f32x4 v0 = acc[ai][bj][m][0], v1 = acc[ai][bj][m][1];
          u32x4 w; w.x = cvtpk(v0[0], v0[1]); w.y = cvtpk(v0[2], v0[3]); w.z = cvtpk(v1[0], v1[1]); w.w = cvtpk(v1[2], v1[3]);
          *(u32x4*)(orow + bj * 128) = w;
        }
      }
  }
};
struct EpiResid {
  static constexpr bool PERM = false, AFTER_DRAIN = false;
  const float* gbase;
  const float* lat_src; const float* ctx_src; float* lat_dst; float* ctx_dst;
  __device__ __forceinline__ void operator()(const f32x4 (&acc)[2][2][4][2], const Unit& u, int wr, int wc, int fr, int fq) const {
    const bool latent = u.pm < 128;
    const int mi = latent ? (u.pm >> 4) : 8;
    const float* gv = gbase + (size_t)mi * 6 * DM + u.pn * 256 + wc * 32 + 4 * fq;
    const float* src = latent ? lat_src : ctx_src;
    float* dst = latent ? lat_dst : ctx_dst;
    const int rbase = (latent ? u.pm : u.pm - 128) * 256 + wr * 64 + fr;
#pragma unroll
    for (int bj = 0; bj < 2; ++bj)
#pragma unroll
      for (int n = 0; n < 2; ++n) {
        const f32x4 gg = *(const f32x4*)(gv + bj * 128 + n * 16);
#pragma unroll
        for (int ai = 0; ai < 2; ++ai)
#pragma unroll
          for (int m = 0; m < 4; ++m) {
            const size_t off = (size_t)(rbase + ai * 128 + m * 16) * DM + u.pn * 256 + bj * 128 + wc * 32 + n * 16 + 4 * fq;
            if (u.flags & 2) {
              const f32x4 v = gg * acc[ai][bj][m][n];
#pragma unroll
              for (int j = 0; j < 4; ++j) __hip_atomic_fetch_add(dst + off + j, v[j], __ATOMIC_RELAXED, __HIP_MEMORY_SCOPE_AGENT);
            } else {
              const f32x4 rsd = *(const f32x4*)(src + off);
              *(f32x4*)(dst + off) = rsd + gg * acc[ai][bj][m][n];
            }
          }
      }
  }
};
}

typedef __attribute__((address_space(3))) unsigned char* lds3_t;

DI void gemm1_phase_pg8(const Params& p, int hb, char* lds, int vcu, int G) {
  pg8::Gemm g{DM, DM};
  pg8::TileOrder S{(const char*)(p.ws + WS_H), (const char*)(p.ws + WS_W + W_IN), (size_t)256 * DM * 2, (size_t)256 * DM * 2, DM / 64, INW / 256, (MH / 256) * (INW / 256), G, vcu, hb};
  const float* ropec = (const float*)(p.ws + WS_ROPE);
  pg8::EpiGemm1 E{(bf16_t*)(p.ws + WS_R + R_P), hb, ropec, ropec + 1024};
  pg8::gemm_phase<pg8::EpiGemm1, pg8::TileOrder, true, true>((lds3_t)lds, g, S, E);
}
DI void gateup_phase_pg8(const Params& p, char* lds, int vcu, int G, int mtiles) {
  pg8::Gemm g{DM, DM};
  pg8::TileOrder S{(const char*)(p.ws + WS_H), (const char*)(p.ws + WS_W + W_GU), (size_t)256 * DM * 2, (size_t)256 * DM * 2, DM / 64, 2 * DFF / 256, mtiles * (2 * DFF / 256), G, vcu, -1};
  pg8::EpiGateUp E{(bf16_t*)(p.ws + WS_R + R_A), (bf16_t*)(p.ws + WS_R + R_UP)};
  pg8::gemm_phase<pg8::EpiGateUp, pg8::TileOrder, true, true>((lds3_t)lds, g, S, E);
}
DI void resid_phase_pg8(const Params& p, int l, const bf16_t* A, const bf16_t* Wt, int K, int gidx,
                        const float* lat_src, const float* ctx_src, float* lat_dst, float* ctx_dst, char* lds, int vcu, int G, int mtiles) {
  pg8::Gemm g{K, K};
  pg8::ResidOrder S{(const char*)A, (const char*)Wt, (size_t)256 * K * 2, (size_t)256 * K * 2, K / 64, (mtiles > 128) ? 544 : 512, G, vcu};
  pg8::EpiResid E{(const float*)(p.ws + WS_MOD) + ((size_t)l * 9 * 6 + gidx) * DM, lat_src, ctx_src, lat_dst, ctx_dst};
  pg8::gemm_phase<pg8::EpiResid, pg8::ResidOrder, true, true>((lds3_t)lds, g, S, E);
}
DI void merge_phase_pg8(const Params& p, int hb, char* lds, int vcu, int G, bool last) {
  pg8::Gemm g{LDP, 512};
  pg8::MergeOrder S{(const char*)(p.ws + WS_R + R_P), (const char*)(p.ws + WS_W + W_BR), last ? 256 : 272, G, vcu};
  pg8::EpiMerge E{(const bf16_t*)(p.ws + WS_R + R_P), (bf16_t*)(p.ws + WS_R + R_Y), hb};
  pg8::gemm_phase<pg8::EpiMerge, pg8::MergeOrder, true, true>((lds3_t)lds, g, S, E);
}

#define LAS __attribute__((address_space(3)))
#define XB_TMO      128
#define XB_XCNT(j)  (256  + 64 * (j))
#define XB_XSUB(j)  (1280 + 64 * (j))
#define XB_XGEN(j)  (2304 + 64 * (j))
#define XB_TOP      3328
#define XB_TOPGEN   3392
#define XCD_BAR_WORDS 3456
#define XB_SPIN_CAP (1u << 18)

__device__ __forceinline__ unsigned xb_ld(unsigned* p)              { return __hip_atomic_load(p, __ATOMIC_RELAXED, __HIP_MEMORY_SCOPE_AGENT); }
__device__ __forceinline__ unsigned xb_add(unsigned* p, unsigned v) { return __hip_atomic_fetch_add(p, v, __ATOMIC_RELAXED, __HIP_MEMORY_SCOPE_AGENT); }
__device__ __forceinline__ unsigned xb_xcc_id() { return (unsigned)__builtin_amdgcn_s_getreg((3 << 11) | 20) & 0xFu; }
#define XB_SPIN(cond, bar) do { unsigned _sp = 0; while (cond) { __builtin_amdgcn_s_sleep(1); \
    if ((++_sp & 255u) == 0u) { if (xb_ld(&(bar)[XB_TMO])) break; if (_sp > XB_SPIN_CAP) { atomicAdd(&(bar)[XB_TMO], 1u); break; } } } } while (0)

struct XcdBarrier {
    unsigned* bar; unsigned x;
    volatile LAS unsigned* st;
};

__device__ __forceinline__ XcdBarrier xcd_barrier_post(unsigned* bar, volatile LAS unsigned* st) {
    XcdBarrier b; b.bar = bar; b.x = xb_xcc_id(); b.st = st;
    if (threadIdx.x == 0) (void)xb_add(&bar[XB_XCNT(b.x)], 1u);
    return b;
}
__device__ __forceinline__ void xcd_barrier_complete(unsigned* bar, unsigned x, unsigned& nloc, unsigned& nx) {
    const unsigned G = gridDim.x * gridDim.y * gridDim.z;
    unsigned sum, cnt, mine, sp = 0u;
    for (;;) {
        sum = 0u; cnt = 0u; mine = 0u;
#pragma unroll
        for (unsigned j = 0; j < 16; ++j) { const unsigned c = xb_ld(&bar[XB_XCNT(j)]); sum += c; cnt += (c > 0u) ? 1u : 0u; mine = (j == x) ? c : mine; }
        if (sum == G) break;
        __builtin_amdgcn_s_sleep(1);
        if ((++sp & 255u) == 0u) { if (xb_ld(&bar[XB_TMO])) break; if (sp > XB_SPIN_CAP) { atomicAdd(&bar[XB_TMO], 1u); break; } }
    }
    nloc = mine > 0u ? mine : 1u; nx = cnt > 0u ? cnt : 1u;
}

__device__ __forceinline__ void xcd_barrier(const XcdBarrier& b) {
    asm volatile("s_waitcnt vmcnt(0)" ::: "memory");
    __syncthreads();
    if (threadIdx.x == 0) {
        unsigned* bar = b.bar;
        __builtin_amdgcn_s_waitcnt(0);
        unsigned nloc = b.st[0], nx = b.st[1];
        if (nloc == 0u) { xcd_barrier_complete(bar, b.x, nloc, nx); b.st[0] = nloc; b.st[1] = nx; }
        const unsigned old = xb_add(&bar[XB_XSUB(b.x)], 1u);
        const unsigned gen = old / nloc;
        if (old + 1u == (gen + 1u) * nloc) {
            __builtin_amdgcn_fence(__ATOMIC_RELEASE, "agent");
            asm volatile("s_waitcnt vmcnt(0)" ::: "memory");
            const unsigned og = xb_add(&bar[XB_TOP], 1u);
            const unsigned tg = og / nx;
            if (og + 1u == (tg + 1u) * nx) xb_add(&bar[XB_TOPGEN], 1u);
            else XB_SPIN(xb_ld(&bar[XB_TOPGEN]) == tg, bar);
            __builtin_amdgcn_fence(__ATOMIC_ACQUIRE, "agent");
            xb_add(&bar[XB_XGEN(b.x)], 1u);
            asm volatile("s_waitcnt vmcnt(0)" ::: "memory");
        } else {
            XB_SPIN(xb_ld(&bar[XB_XGEN(b.x)]) == gen, bar);
            __builtin_amdgcn_fence(__ATOMIC_ACQUIRE, "agent");
            asm volatile("s_waitcnt vmcnt(0)" ::: "memory");
        }
    }
    __syncthreads();
}

#define gbar(b_) xcd_barrier(b_)

template <int VD, int NKH, bool GQA>
DI void attn_unit(const Params& p, int l, bf16_t* P, int qrow0, int qcol_base, int kcol0, int kcol1, int vcol, int ocol_base,
                  int ctx_row0, int nctx_t, int lat_row0, int ntiles  , int qpos0, int kpos0, bool masked, float sink_raw0, float sink_raw1,
                  int hd, char* lds, int rot = 0) {
  const int tid = opaque_tid(), lane = tid & 63, wave = tid >> 6, r = lane & 31, h = lane >> 5;
  const int qs = wave & 3, sub = wave >> 2;
  constexpr int KP = 144, VP = (VD == 128) ? 320 : 192;
  constexpr int KBYTES = 64 * KP, VBYTES = 64 * VP, STAGE = NKH * KBYTES + VBYTES;
  constexpr int NDB = VD / 32, NVC = VD / 64;
  const int qcol = qcol_base + sub * 64;
  bf16x8 qf[4];
  {
    const bf16_t* qp = P + (size_t)(qrow0 + qs * 32 + r) * LDP + qcol + h * 8;
#pragma unroll
    for (int ds = 0; ds < 4; ++ds) qf[ds] = *(const bf16x8*)(qp + ds * 16);
  }
  const int krow = tid >> 3, kch = tid & 7;
  u32x4 rkA[NKH], rvA[NVC];
  auto tile_row = [&](int t) -> int { int x = t + rot; if (x >= ntiles) x -= ntiles; return (x < nctx_t) ? ctx_row0 + 64 * x : lat_row0 + 64 * (x - nctx_t); };
#define ATT_LOAD(rk, rv, t_) do { const int tr_ = tile_row(t_); \
    rk[0] = *(const u32x4*)(P + (size_t)(tr_ + krow) * LDP + kcol0 + kch * 8); \
    if (NKH == 2) rk[NKH - 1] = *(const u32x4*)(P + (size_t)(tr_ + krow) * LDP + kcol1 + kch * 8); \
    if (VD == 128) { rv[0] = *(const u32x4*)(P + (size_t)(tr_ + (tid >> 4)) * LDP + vcol + (tid & 15) * 8); \
                     rv[NVC - 1] = *(const u32x4*)(P + (size_t)(tr_ + 32 + (tid >> 4)) * LDP + vcol + (tid & 15) * 8); } \
    else { rv[0] = *(const u32x4*)(P + (size_t)(tr_ + krow) * LDP + vcol + kch * 8); } } while (0)
#define ATT_STORE(rk, rv, st_) do { char* s_ = (st_); \
    *(u32x4*)(s_ + krow * KP + kch * 16) = rk[0]; \
    if (NKH == 2) *(u32x4*)(s_ + KBYTES + krow * KP + kch * 16) = rk[NKH - 1]; \
    if (VD == 128) { *(u32x4*)(s_ + NKH * KBYTES + (tid >> 4) * VP + (tid & 15) * 16) = rv[0]; \
                     *(u32x4*)(s_ + NKH * KBYTES + (32 + (tid >> 4)) * VP + (tid & 15) * 16) = rv[NVC - 1]; } \
    else { *(u32x4*)(s_ + NKH * KBYTES + krow * VP + kch * 16) = rv[0]; } } while (0)

  f32x16 o[NDB];
#pragma unroll
  for (int db = 0; db < NDB; ++db)
#pragma unroll
    for (int i = 0; i < 16; ++i) o[db][i] = 0.f;
  float m = 0.f, lsum = 0.f;
  if (GQA) { const float sk = sub ? sink_raw1 : sink_raw0; lsum = (h == 0) ? ex2(sk * LOG2E) : 0.0f; }
  bool mnz = false;
  const int qpos = qpos0 + qs * 32 + r;
  const int kh = (NKH == 2) ? sub : 0;
  const int q4 = (lane & 15) >> 2, p4 = lane & 3, blk = (lane >> 4) & 1;
  const int voff = (4 * h + q4) * VP + (16 * blk + 4 * p4) * 2;
  const int koff = kh * KBYTES + r * KP + h * 16;

  auto compute = [&](const char* cur, int t) __attribute__((always_inline)) {
    const char* Kb = cur + koff;
    bf16x8 kf[8];
#pragma unroll
    for (int ds = 0; ds < 4; ++ds) { kf[2 * ds] = *(const bf16x8*)(Kb + ds * 32); kf[2 * ds + 1] = *(const bf16x8*)(Kb + 32 * KP + ds * 32); }
    f32x16 zz;
#pragma unroll
    for (int i = 0; i < 16; ++i) zz[i] = 0.f;
    f32x16 s0 = mfma32(kf[0], qf[0], zz), s1 = mfma32(kf[1], qf[0], zz);
#pragma unroll
    for (int ds = 1; ds < 4; ++ds) { s0 = mfma32(kf[2 * ds], qf[ds], s0); s1 = mfma32(kf[2 * ds + 1], qf[ds], s1); }
    const char* Vb = cur + NKH * KBYTES + voff;
    s16x4 vlo[2][4], vhi[2][4];
#pragma unroll
    for (int ks = 0; ks < 4; ++ks) { vlo[0][ks] = tr_read(Vb + (ks * 16) * VP); vhi[0][ks] = tr_read(Vb + (ks * 16 + 8) * VP); }
    __builtin_amdgcn_sched_barrier(0);
    const int tk0 = kpos0 + 64 * (t - nctx_t), wq0 = qpos0 + qs * 32;
    if (GQA && masked && t >= nctx_t && (tk0 + 63 - wq0 > 128 || wq0 + 31 - tk0 > 128)) {
      const int kb0 = kpos0 + 64 * (t - nctx_t) + 4 * h - qpos;
#pragma unroll
      for (int i = 0; i < 16; ++i) {
        const int rel = kb0 + (i & 3) + 8 * (i >> 2);
        if (rel > 128 || rel < -128) s0[i] = -1e30f;
        if (rel + 32 > 128 || rel + 32 < -128) s1[i] = -1e30f;
      }
    }
    if (mnz) {
#pragma unroll
      for (int i = 0; i < 16; ++i) { s0[i] -= m; s1[i] -= m; }
    }
    float mx;
    {
      float a = fmaxf(s0[0], s1[0]), b = fmaxf(s0[1], s1[1]);
#pragma unroll
      for (int i = 2; i < 16; i += 2) { a = __builtin_fmaxf(__builtin_fmaxf(a, s0[i]), s1[i]); b = __builtin_fmaxf(__builtin_fmaxf(b, s0[i + 1]), s1[i + 1]); }
      mx = fmaxf(a, b);
    }
    { const auto rr = __builtin_amdgcn_permlane32_swap(__float_as_uint(mx), __float_as_uint(mx), false, false); mx = fmaxf(__uint_as_float(rr[0]), __uint_as_float(rr[1])); }
    if (__builtin_amdgcn_ballot_w64(mx > 8.0f) != 0) {
      const float d = fmaxf(mx, 0.f);
      const float alpha = ex2(-d);
      m += d; lsum *= alpha;
#pragma unroll
      for (int db = 0; db < NDB; ++db)
#pragma unroll
        for (int i = 0; i < 16; ++i) o[db][i] *= alpha;
#pragma unroll
      for (int i = 0; i < 16; ++i) { s0[i] -= d; s1[i] -= d; }
      mnz = true;
    }
#pragma unroll
    for (int i = 0; i < 16; ++i) { s0[i] = ex2(s0[i]); s1[i] = ex2(s1[i]); }
    {
      f32x2_t a2 = {s0[0], s0[1]}, b2 = {s1[0], s1[1]};
#pragma unroll
      for (int i = 2; i < 16; i += 2) { a2 += (f32x2_t){s0[i], s0[i + 1]}; b2 += (f32x2_t){s1[i], s1[i + 1]}; }
      a2 += b2;
      lsum += a2.x + a2.y;
    }
    bf16x8 pk[4];
    {
      u32x4 w;
      w.x = cvtpk(s0[0], s0[1]); w.y = cvtpk(s0[2], s0[3]); w.z = cvtpk(s0[4], s0[5]); w.w = cvtpk(s0[6], s0[7]); pk[0] = __builtin_bit_cast(bf16x8, w);
      w.x = cvtpk(s0[8], s0[9]); w.y = cvtpk(s0[10], s0[11]); w.z = cvtpk(s0[12], s0[13]); w.w = cvtpk(s0[14], s0[15]); pk[1] = __builtin_bit_cast(bf16x8, w);
      w.x = cvtpk(s1[0], s1[1]); w.y = cvtpk(s1[2], s1[3]); w.z = cvtpk(s1[4], s1[5]); w.w = cvtpk(s1[6], s1[7]); pk[2] = __builtin_bit_cast(bf16x8, w);
      w.x = cvtpk(s1[8], s1[9]); w.y = cvtpk(s1[10], s1[11]); w.z = cvtpk(s1[12], s1[13]); w.w = cvtpk(s1[14], s1[15]); pk[3] = __builtin_bit_cast(bf16x8, w);
    }
#pragma unroll
    for (int db = 0; db < NDB; ++db) {
      if (db + 1 < NDB) {
#pragma unroll
        for (int ks = 0; ks < 4; ++ks) { vlo[(db + 1) & 1][ks] = tr_read(Vb + (ks * 16) * VP + (db + 1) * 64); vhi[(db + 1) & 1][ks] = tr_read(Vb + (ks * 16 + 8) * VP + (db + 1) * 64); }
      }
#pragma unroll
      for (int ks = 0; ks < 4; ++ks) {
        const bf16x8 vf = __builtin_shufflevector(vlo[db & 1][ks], vhi[db & 1][ks], 0, 1, 2, 3, 4, 5, 6, 7);
        o[db] = mfma32(vf, pk[ks], o[db]);
      }
      __builtin_amdgcn_sched_barrier(0);
    }
  };

  ATT_LOAD(rkA, rvA, 0); ATT_STORE(rkA, rvA, lds);
  __syncthreads();
  if (wave >= 4) __builtin_amdgcn_s_setprio(1);
  for (int t = 0; t < ntiles; ++t) {
    char* cur = lds + (t & 1) * STAGE;
    char* nxt = lds + ((t + 1) & 1) * STAGE;
    const bool more = (t + 1) < ntiles;
    if (more) ATT_LOAD(rkA, rvA, t + 1);
    compute(cur, t);
    if (more) ATT_STORE(rkA, rvA, nxt);
    __syncthreads();
  }
#undef ATT_LOAD
#undef ATT_STORE
  __builtin_amdgcn_s_setprio(0);
  lsum += __shfl_xor(lsum, 32);
  const float inv = 1.0f / lsum;
  const int orow = qrow0 + qs * 32 + r;
  if (GQA) {
    bf16_t* op = P + (size_t)orow * LDP + ocol_base + sub * 64 + 4 * h;
#pragma unroll
    for (int db = 0; db < NDB; ++db)
#pragma unroll
      for (int g4 = 0; g4 < 4; ++g4) {
        u32x2 w; w.x = cvtpk(o[db][4 * g4] * inv, o[db][4 * g4 + 1] * inv); w.y = cvtpk(o[db][4 * g4 + 2] * inv, o[db][4 * g4 + 3] * inv);
        *(u32x2*)(op + db * 32 + 8 * g4) = w;
      }
    __syncthreads();
  } else {
    float* xb = (float*)lds + (size_t)qs * (NDB * 16) * 64 + lane;
    if (sub == 1) {
#pragma unroll
      for (int db = 0; db < NDB; ++db)
#pragma unroll
        for (int i = 0; i < 16; ++i) xb[(db * 16 + i) * 64] = o[db][i] * inv;
    }
    __syncthreads();
    if (sub == 0) {
      const float lam = ((const float*)(p.ws + WS_LAM))[l];
      const float lam_init = 0.8f - 0.6f * __expf(-0.3f * (float)l);
      float ss = 0.f;
#pragma unroll
      for (int db = 0; db < NDB; ++db)
#pragma unroll
        for (int i = 0; i < 16; ++i) { const float v = o[db][i] * inv - lam * xb[(db * 16 + i) * 64]; o[db][i] = v; ss += v * v; }
      ss += __shfl_xor(ss, 32);
      const float rstd = (1.0f / sqrtf(ss * (1.0f / VD) + EPS)) * (1.0f - lam_init);
      const float* sg = p.diff_subln_g + l * 128 + 4 * h;
      bf16_t* op = P + (size_t)orow * LDP + ocol_base + 4 * h;
#pragma unroll
      for (int db = 0; db < NDB; ++db)
#pragma unroll
        for (int g4 = 0; g4 < 4; ++g4) {
          const f32x4 gv = *(const f32x4*)(sg + db * 32 + 8 * g4);
          u32x2 w; w.x = cvtpk(o[db][4 * g4] * rstd * gv.x, o[db][4 * g4 + 1] * rstd * gv.y); w.y = cvtpk(o[db][4 * g4 + 2] * rstd * gv.z, o[db][4 * g4 + 3] * rstd * gv.w);
          *(u32x2*)(op + db * 32 + 8 * g4) = w;
        }
    }
    __syncthreads();
  }
}

DI void sgu_unit(const Params& p, int l, bf16_t* P, int lr0, int g, char* lds) {
  const int tid = opaque_tid(), lane = tid & 63, wave = tid >> 6, r16 = lane & 15, quad = lane >> 4;
  constexpr int PITCH = 288;
  char* Al = lds;
  char* Bl = lds + 128 * PITCH;
  float* st = (float*)(lds + 2 * 128 * PITCH);
  {
    const int row = tid >> 2, part = tid & 3;
    const bf16_t* vp = P + (size_t)(lr0 + row) * LDP + COL_AV + part * 128;
    float s = 0.f, s2 = 0.f;
#pragma unroll 4
    for (int i = 0; i < 16; ++i) {
      const u32x4 w = *(const u32x4*)(vp + i * 8);
#pragma unroll
      for (int j = 0; j < 4; ++j) { const float a = bf_lo(w[j]), b = bf_hi(w[j]); s += a + b; s2 += a * a + b * b; }
    }
    s += __shfl_xor(s, 1); s2 += __shfl_xor(s2, 1); s += __shfl_xor(s, 2); s2 += __shfl_xor(s2, 2);
    const float mean = s * (1.0f / 512.0f); const float var = fmaxf(s2 * (1.0f / 512.0f) - mean * mean, 0.f);
    if (part == 0) { st[row * 2] = mean; st[row * 2 + 1] = 1.0f / sqrtf(var + EPS); }
    const float* wsrc = p.w_s + ((size_t)(l * 4 + g) * 128 + row) * 128 + part * 32;
#pragma unroll
    for (int i = 0; i < 4; ++i) {
      const f32x4 a = *(const f32x4*)(wsrc + i * 8), b = *(const f32x4*)(wsrc + i * 8 + 4);
      u32x4 w; w.x = cvtpk(a.x, a.y); w.y = cvtpk(a.z, a.w); w.z = cvtpk(b.x, b.y); w.w = cvtpk(b.z, b.w);
      *(u32x4*)(Al + row * PITCH + (part * 32 + i * 8) * 2) = w;
    }
  }
  __syncthreads();
  {
    const int q = tid & 127, cgp = tid >> 7;
    const float mean = st[q * 2], rstd = st[q * 2 + 1];
    const float* lg = p.sgu_ln_g + l * 512 + g * 128;
    const float* lb = p.sgu_ln_b + l * 512 + g * 128;
#pragma unroll
    for (int ps = 0; ps < 4; ++ps) {
      const int c0 = (cgp + 4 * ps) * 8;
      const u32x4 w = *(const u32x4*)(P + (size_t)(lr0 + q) * LDP + COL_AV + g * 128 + c0);
#pragma unroll
      for (int j = 0; j < 4; ++j) {
        const float a = (bf_lo(w[j]) - mean) * rstd * lg[c0 + 2 * j] + lb[c0 + 2 * j];
        const float b = (bf_hi(w[j]) - mean) * rstd * lg[c0 + 2 * j + 1] + lb[c0 + 2 * j + 1];
        const unsigned pkd = cvtpk(a, b);
        *(bf16_t*)(Bl + (c0 + 2 * j) * PITCH + q * 2) = (bf16_t)(pkd & 0xffffu);
        *(bf16_t*)(Bl + (c0 + 2 * j + 1) * PITCH + q * 2) = (bf16_t)(pkd >> 16);
      }
    }
  }
  __syncthreads();
  const int pw = (wave >> 1) * 32, cw = (wave & 1) * 64;
  f32x4 acc[2][4];
#pragma unroll
  for (int mt = 0; mt < 2; ++mt)
#pragma unroll
    for (int nt = 0; nt < 4; ++nt) acc[mt][nt] = (f32x4){0.f, 0.f, 0.f, 0.f};
#pragma unroll
  for (int ks = 0; ks < 4; ++ks) {
    bf16x8 af[2], bfr[4];
#pragma unroll
    for (int mt = 0; mt < 2; ++mt) af[mt] = *(const bf16x8*)(Al + (pw + mt * 16 + r16) * PITCH + ks * 64 + quad * 16);
#pragma unroll
    for (int nt = 0; nt < 4; ++nt) bfr[nt] = *(const bf16x8*)(Bl + (cw + nt * 16 + r16) * PITCH + ks * 64 + quad * 16);
#pragma unroll
    for (int mt = 0; mt < 2; ++mt)
#pragma unroll
      for (int nt = 0; nt < 4; ++nt) acc[mt][nt] = mfma16(bfr[nt], af[mt], acc[mt][nt]);
  }
#pragma unroll
  for (int mt = 0; mt < 2; ++mt) {
    const int pr = pw + mt * 16 + r16;
    const float bs = p.b_s[(l * 4 + g) * 128 + pr];
    bf16_t* up = P + (size_t)(lr0 + pr) * LDP + COL_AU + g * 128 + cw + quad * 4;
#pragma unroll
    for (int nt = 0; nt < 4; ++nt) {
      const u32x2 uw = *(const u32x2*)(up + nt * 16);
      u32x2 w; w.x = cvtpk(bf_lo(uw.x) * (acc[mt][nt][0] + bs), bf_hi(uw.x) * (acc[mt][nt][1] + bs));
      w.y = cvtpk(bf_lo(uw.y) * (acc[mt][nt][2] + bs), bf_hi(uw.y) * (acc[mt][nt][3] + bs));
      *(u32x2*)(up + nt * 16) = w;
    }
  }
  __syncthreads();
}

DI void mixers_phase(const Params& p, int l, int hb, char* lds, int vcu, int G, bool last) {
  bf16_t* P = (bf16_t*)(p.ws + WS_R + R_P);
  constexpr int N_DL = 512, N_GL = 512;
  const int N_SG = last ? (HALF_LAT / 128) * 4 : (MH / 128) * 4, N_DC = last ? 0 : 32, N_GC = last ? 0 : 32;
#pragma unroll 1
  for (int idx = vcu; idx < N_DL; idx += G) {
    const int bl = idx >> 7, hd = (idx >> 5) & 3, qb = idx & 31;
    attn_unit<128, 2, false>(p, l, P, bl * SEQ + qb * 128, COL_BQ + hd * 128, COL_BK + hd * 128, COL_BK + hd * 128 + 64, COL_BV + hd * 128, COL_BQ + hd * 128,
                             HALF_LAT + bl * NCTX, 4, bl * SEQ, 4 + SEQ / 64, 0, 0, false, 0.f, 0.f, hd, lds, (qb * 2) % (4 + SEQ / 64));
  }
#pragma unroll 1
  for (int idx = (vcu + G - 32 % G) % G; idx < N_DC; idx += G) {
    const int bl = idx >> 3, hd = (idx >> 1) & 3, qb = idx & 1;
    attn_unit<128, 2, false>(p, l, P, HALF_LAT + bl * NCTX + qb * 128, COL_BQ + hd * 128, COL_BK + hd * 128, COL_BK + hd * 128 + 64, COL_BV + hd * 128, COL_BQ + hd * 128,
                             HALF_LAT + bl * NCTX, 4, 0, 4, 0, 0, false, 0.f, 0.f, hd, lds);
  }
#pragma unroll 1
  for (int idx = vcu; idx < N_GL; idx += G) {
    const int bl = idx >> 7, kvh = (idx >> 6) & 1, n = (idx >> 1) & 31, gp = idx & 1;
    const int start = n * 128;
    const int lo = (start - 128 < 0) ? 0 : start - 128, hi = (start + 256 > SEQ) ? SEQ : start + 256;
    const int hq = kvh * 4 + gp * 2;
    const float sk0 = p.sinks[l * 8 + hq], sk1 = p.sinks[l * 8 + hq + 1];
    attn_unit<64, 1, true>(p, l, P, bl * SEQ + start, COL_CQ + hq * 64, COL_CK + kvh * 64, 0, COL_CV + kvh * 64, COL_CQ + hq * 64,
                           HALF_LAT + bl * NCTX, 4, bl * SEQ + lo, 4 + (hi - lo) / 64, start, lo, true, sk0, sk1, 0, lds);
  }
#pragma unroll 1
  for (int idx = (vcu + G - 64 % G) % G; idx < N_GC; idx += G) {
    const int bl = idx >> 3, kvh = (idx >> 2) & 1, qb = (idx >> 1) & 1, gp = idx & 1;
    const int hq = kvh * 4 + gp * 2;
    const float sk0 = p.sinks[l * 8 + hq], sk1 = p.sinks[l * 8 + hq + 1];
    attn_unit<64, 1, true>(p, l, P, HALF_LAT + bl * NCTX + qb * 128, COL_CQ + hq * 64, COL_CK + kvh * 64, 0, COL_CV + kvh * 64, COL_CQ + hq * 64,
                           HALF_LAT + bl * NCTX, 4, 0, 4, 0, 0, false, sk0, sk1, 0, lds);
  }
#pragma unroll 1
  for (int idx = vcu; idx < N_SG; idx += G) sgu_unit(p, l, P, (idx >> 2) * 128, idx & 3, lds);
}

template <int HB>
DI void half_fwd(const Params& p, int l, const XcdBarrier& bar, char* lds, int vcu, int G) {
  const bool last = (l == DEPTH - 1);
  gemm1_phase_pg8(p, HB, lds, vcu, G);
  gbar(bar);
  mixers_phase(p, l, HB, lds, vcu, G, last);
  gbar(bar);
  merge_phase_pg8(p, HB, lds, vcu, G, last);
  gbar(bar);
}
template <int L>
DI void layer_fwd(const Params& p, const XcdBarrier& bar, char* lds, int vcu, int G) {
  constexpr int l = L;
  constexpr int nrows = (L == DEPTH - 1) ? NLAT : MTOT;
  float* ctxs = (float*)(p.ws + WS_CTX);
  const float* lat_src = (l == 0) ? p.x : p.out;
  const float* ctx_src = ctxs;
  if (l > 0) convert_weights(p, l, lds, vcu, G);
  norm_phase(p, l, 0, lat_src, ctx_src, vcu, G, MTOT);
  gbar(bar);
  half_fwd<0>(p, l, bar, lds, vcu, G);
  half_fwd<1>(p, l, bar, lds, vcu, G);
  resid_phase_pg8(p, l, (const bf16_t*)(p.ws + WS_R + R_Y), (const bf16_t*)(p.ws + WS_W + W_OUT), DM, 2, lat_src, ctx_src, p.out, ctxs, lds, vcu, G, nrows / 256);
  gbar(bar);
  norm_phase(p, l, 1, p.out, ctxs, vcu, G, nrows);
  gbar(bar);
  gateup_phase_pg8(p, lds, vcu, G, nrows / 256);
  gbar(bar);
  conv_phase(p, l, vcu, G, nrows);
  gbar(bar);
  resid_phase_pg8(p, l, (const bf16_t*)(p.ws + WS_R + R_UP), (const bf16_t*)(p.ws + WS_W + W_DN), DFF, 5, p.out, ctxs, p.out, ctxs, lds, vcu, G, nrows / 256);
  gbar(bar);
}

__global__ void __launch_bounds__(512) mega_fwd(Params p) {
  extern __shared__ __attribute__((aligned(16))) unsigned char lds_raw[];
  char* lds = (char*)lds_raw;
  cg::grid_group grid = cg::this_grid();
  const int tid = opaque_tid();
  const int G = gridDim.x, bx = blockIdx.x;
  int vcu = (G % 8 == 0) ? (bx % 8) * (G / 8) + bx / 8 : bx;
  float* ctxs = (float*)(p.ws + WS_CTX);
  if (tid < 64) ((LAS unsigned*)(lds_raw + LDS_MISC))[tid] = 0u;
  __syncthreads();
  unsigned* xcnt = (unsigned*)(p.ws + WS_BAR + 14336);
  const unsigned myx = xb_xcc_id();
  if (tid == 0) ((LAS unsigned*)(lds_raw + LDS_MISC))[16] = __hip_atomic_fetch_add(xcnt + myx, 1u, __ATOMIC_RELAXED, __HIP_MEMORY_SCOPE_AGENT);
  const XcdBarrier bar = xcd_barrier_post((unsigned*)(p.ws + WS_BAR), (volatile LAS unsigned*)(lds_raw + LDS_MISC) + 8);

  if (bx == 0) {
    float* rc = (float*)(p.ws + WS_ROPE);
    for (int e = tid; e < 1024; e += 512) {
      const int pos = e >> 4, i = e & 15;
      const float inv = powf(10000.0f, -(float)(2 * i) / 32.0f);
      const float ang = (float)pos * inv;
      rc[e] = cosf(ang); rc[1024 + e] = sinf(ang);
    }
  }
  if (bx == 1 && tid < DEPTH) {
    float s1 = 0.f, s2 = 0.f;
    for (int i = 0; i < 64; ++i) { s1 += p.lam_q1[tid * 64 + i] * p.lam_k1[tid * 64 + i]; s2 += p.lam_q2[tid * 64 + i] * p.lam_k2[tid * 64 + i]; }
    const float lam_init = 0.8f - 0.6f * expf(-0.3f * (float)tid);
    ((float*)(p.ws + WS_LAM))[tid] = expf(s1) - expf(s2) + lam_init;
  }
  for (int i = vcu * 512 + tid; i < NCTXR * DM / 4; i += G * 512) ((f32x4*)ctxs)[i] = ((const f32x4*)p.ctx)[i];
  ada_phase(p, lds, vcu, G);
  convert_weights(p, 0, lds, vcu, G);
  grid.sync();
  {
    if (tid == 0) {
      unsigned pre = 0u;
      for (unsigned j = 0; j < 16u; ++j) { const unsigned cj = __hip_atomic_load(xcnt + j, __ATOMIC_RELAXED, __HIP_MEMORY_SCOPE_AGENT); if (j < myx) pre += cj; }
      ((LAS unsigned*)(lds_raw + LDS_MISC))[17] = pre + ((LAS unsigned*)(lds_raw + LDS_MISC))[16];
    }
    __syncthreads();
    vcu = (int)((LAS unsigned*)(lds_raw + LDS_MISC))[17];
    vcu = __builtin_amdgcn_readfirstlane(vcu);
  }

  layer_fwd<0>(p, bar, lds, vcu, G);
  layer_fwd<1>(p, bar, lds, vcu, G);
  layer_fwd<2>(p, bar, lds, vcu, G);
  layer_fwd<3>(p, bar, lds, vcu, G);
  const int tid2 = opaque_tid(), lane = tid2 & 63;
  for (int row = vcu * 8 + (tid2 >> 6); row < NLAT; row += G * 8) {
    float* xr = p.out + (size_t)row * DM;
    f32x4 v[4]; float ss = 0.f;
#pragma unroll
    for (int j = 0; j < 4; ++j) { v[j] = ((const f32x4*)xr)[lane + 64 * j]; ss += (v[j].x * v[j].x + v[j].y * v[j].y) + (v[j].z * v[j].z + v[j].w * v[j].w); }
    const float rstd = 1.0f / sqrtf(wave_sum(ss) * (1.0f / DM) + EPS);
#pragma unroll
    for (int j = 0; j < 4; ++j) { const f32x4 gg = ((const f32x4*)p.final_g)[lane + 64 * j]; ((f32x4*)xr)[lane + 64 * j] = v[j] * rstd * gg; }
  }
}

extern "C" void kernel_launch(void* const* d_in, const int* in_sizes, int n_in, void* d_out, int out_size, void* d_ws, size_t ws_size, hipStream_t stream) {
  static int grid = 0;
  if (grid == 0) {
    if (n_in != 27 || in_sizes[0] != NLAT * DM || out_size != NLAT * DM || ws_size < WS_END) {
      fprintf(stderr, "kernel_launch: unexpected shapes (n_in %d, in0 %d, out %d, ws %zu, need %zu)\n", n_in, n_in > 0 ? in_sizes[0] : -1, out_size, ws_size, (size_t)WS_END);
      grid = -1; return;
    }
    int dev = 0, cus = 0, per_cu = 0;
    hipGetDevice(&dev);
    hipDeviceGetAttribute(&cus, hipDeviceAttributeMultiprocessorCount, dev);
    hipFuncSetAttribute((const void*)mega_fwd, hipFuncAttributeMaxDynamicSharedMemorySize, LDS_BYTES);
    hipOccupancyMaxActiveBlocksPerMultiprocessor(&per_cu, (const void*)mega_fwd, 512, LDS_BYTES);
    if (per_cu < 1) per_cu = 1;
    grid = cus * per_cu;
  }
  if (grid < 0) return;
  Params p{};
  const float** pp = (const float**)&p;
  for (int i = 0; i < 27; ++i) pp[i] = (const float*)d_in[i];
  p.out = (float*)d_out; p.ws = (unsigned char*)d_ws;
  (void)hipMemsetAsync((unsigned char*)d_ws + WS_BAR, 0, 16384, stream);
  void* args[] = {&p};
  hipError_t e = hipLaunchCooperativeKernel((const void*)mega_fwd, dim3(grid), dim3(512), args, LDS_BYTES, stream);
  if (e != hipSuccess) fprintf(stderr, "cooperative launch failed: %s (grid %d)\n", hipGetErrorString(e), grid);
}
```

```cpp
#include <hip/hip_runtime.h>
#include <hip/hip_cooperative_groups.h>
#include <cstdio>
#include <cstdint>
namespace cg = cooperative_groups;

#define DI __device__ __forceinline__
typedef unsigned short bf16_t;
typedef short bf16x8 __attribute__((ext_vector_type(8)));
typedef short s16x4 __attribute__((ext_vector_type(4)));
typedef short v4i16_t __attribute__((ext_vector_type(4)));
typedef float f32x4 __attribute__((ext_vector_type(4)));
typedef float f32x16 __attribute__((ext_vector_type(16)));
typedef unsigned u32x4 __attribute__((ext_vector_type(4)));
typedef unsigned u32x2 __attribute__((ext_vector_type(2)));
typedef float f32x2_t __attribute__((ext_vector_type(2)));
typedef __bf16 bf16x2_t __attribute__((ext_vector_type(2)));

constexpr int DM = 1024, NBATCH = 8, SEQ = 4096, NCTX = 256, DEPTH = 4;
constexpr int NLAT = NBATCH * SEQ;
constexpr int NCTXR = NBATCH * NCTX;
constexpr int MTOT = NLAT + NCTXR;
constexpr int INW = 6400, LDP = 6464;
constexpr int HALF_LAT = NLAT / 2, HALF_CTX = NCTXR / 2, MH = HALF_LAT + HALF_CTX;
constexpr int DFF = 2816;
constexpr int COL_AU = 0, COL_AV = 512, COL_BQ = 1024, COL_BK = 1536, COL_BV = 2048, COL_CQ = 2560, COL_CK = 3072, COL_CV = 3200, COL_G = 3328;
constexpr float EPS = 1e-6f;
constexpr float LOG2E = 1.4426950408889634f;
constexpr float SM_C = 0.125f * LOG2E;

constexpr size_t MiB = 1u << 20;
constexpr size_t WS_MOD = 0;
constexpr size_t WS_ROPE = 1 * MiB;
constexpr size_t WS_LAM = 1 * MiB + 16384;
constexpr size_t WS_BAR = 1 * MiB + 32768;
constexpr size_t WS_W = 2 * MiB;
constexpr size_t W_IN = 0, W_BR = W_IN + (size_t)INW * DM * 2, W_OUT = W_BR + (size_t)3 * DM * 512 * 2, W_GU = W_OUT + (size_t)DM * DM * 2,
                 W_DN = W_GU + (size_t)2 * DFF * DM * 2, W_END = W_DN + (size_t)DM * DFF * 2;
static_assert(W_END <= 34 * MiB, "weights region");
constexpr size_t WS_CTX = 36 * MiB;
constexpr size_t WS_H = 44 * MiB;
constexpr size_t WS_R = 112 * MiB;
constexpr size_t R_P = 0, R_Y = 216 * MiB;
constexpr size_t R_A = 0, R_UP = (size_t)MTOT * DFF * 2;
constexpr size_t WS_END = WS_R + 374 * MiB;
static_assert((size_t)MH * LDP * 2 <= 216 * MiB && R_Y + (size_t)MTOT * DM * 2 <= 374 * MiB && 2 * (size_t)MTOT * DFF * 2 <= 374 * MiB, "R region");

constexpr int LDS_BYTES = 131072 + 256;
constexpr int LDS_MISC = 131072;

struct Params {
  const float *x, *c, *ctx, *c_ctx, *w_ada, *b_ada, *norm1_g, *w_in, *sgu_ln_g, *sgu_ln_b, *w_s, *b_s, *lam_q1, *lam_k1, *lam_q2, *lam_k2,
      *diff_subln_g, *sinks, *w_branch, *w_out, *norm2_g, *w_gate, *conv_w, *conv_b, *w_up, *w_down, *final_g;
  float* out; unsigned char* ws;
};

DI unsigned cvtpk(float lo, float hi) { f32x2_t v = {lo, hi}; bf16x2_t b = __builtin_convertvector(v, bf16x2_t); return __builtin_bit_cast(unsigned, b); }
DI float bf_lo(unsigned w) { return __uint_as_float(w << 16); }
DI float bf_hi(unsigned w) { return __uint_as_float(w & 0xffff0000u); }
DI float ex2(float v) { return __builtin_amdgcn_exp2f(v); }
DI float fast_rcp(float v) { return __builtin_amdgcn_rcpf(v); }
DI float sigmoidf_(float v) { return fast_rcp(1.0f + ex2(-v * LOG2E)); }
DI float gelu_tanh(float v) { const float u = 0.7978845608028654f * (v + 0.044715f * v * v * v); return v * fast_rcp(1.0f + ex2(-2.0f * LOG2E * u)); }
DI float siluf_(float v) { return v * sigmoidf_(v); }
DI int opaque_tid() { int t = threadIdx.x; asm volatile("" : "+v"(t)); return t; }
DI float wave_sum(float v) {
#pragma unroll
  for (int o = 1; o < 64; o <<= 1) v += __shfl_xor(v, o);
  return v;
}
DI f32x4 mfma16(bf16x8 a, bf16x8 b, f32x4 c) { return __builtin_amdgcn_mfma_f32_16x16x32_bf16(a, b, c, 0, 0, 0); }
DI f32x16 mfma32(bf16x8 a, bf16x8 b, f32x16 c) { return __builtin_amdgcn_mfma_f32_32x32x16_bf16(a, b, c, 0, 0, 0); }
DI s16x4 tr_read(const char* p) { return __builtin_bit_cast(s16x4, __builtin_amdgcn_ds_read_tr16_b64_v4i16((__attribute__((address_space(3))) v4i16_t*)(uintptr_t)p)); }

template <int WNT>
DI void gemm_core(f32x4 (&acc)[8][WNT], const bf16_t* __restrict__ A, int lda, const bf16_t* __restrict__ B, int ldb, int K, char* lds) {
  const int tid = opaque_tid(), lane = tid & 63, wave = tid >> 6;
  const int wm = wave >> 2, wn = wave & 3, r16 = lane & 15, quad = lane >> 4;
  constexpr int BROWS = 64 * WNT;
  constexpr int STAGE = 16384 + BROWS * 64;
  const int srow = tid >> 2, skq = tid & 3;
  const int soff = srow * 64 + ((skq ^ ((4 - ((srow >> 2) & 3)) & 3)) * 16);
  const bf16_t* ga0 = A + (size_t)srow * lda + skq * 8;
  const bf16_t* ga1 = A + (size_t)(srow + 128) * lda + skq * 8;
  const bf16_t* gb0 = B + (size_t)srow * ldb + skq * 8;
  const bf16_t* gb1 = B + (size_t)(srow + 128) * ldb + skq * 8;
  const int rsw = ((quad ^ ((4 - ((r16 >> 2) & 3)) & 3)) * 16);
  const int aoff = (wm * 128 + r16) * 64 + rsw;
  const int boff = 16384 + (wn * 16 * WNT + r16) * 64 + rsw;
  u32x4 ra0, ra1, rb0, rb1;
  ra0 = *(const u32x4*)ga0; ra1 = *(const u32x4*)ga1;
  rb0 = *(const u32x4*)gb0; rb1 = rb0;
  if (WNT == 4) rb1 = *(const u32x4*)gb1;
  *(u32x4*)(lds + soff) = ra0; *(u32x4*)(lds + soff + 128 * 64) = ra1;
  if (WNT == 4) { *(u32x4*)(lds + 16384 + soff) = rb0; *(u32x4*)(lds + 16384 + soff + 128 * 64) = rb1; }
  else { *(u32x4*)(lds + 16384 + soff) = rb0; }
  __syncthreads();
  const int nk = K >> 5;
  for (int kt = 0; kt < nk; ++kt) {
    char* cur = lds + (kt & 1) * STAGE;
    char* nxt = lds + ((kt + 1) & 1) * STAGE;
    const bool more = (kt + 1) < nk;
    if (more) {
      const int ko = (kt + 1) * 32;
      ra0 = *(const u32x4*)(ga0 + ko); ra1 = *(const u32x4*)(ga1 + ko);
      rb0 = *(const u32x4*)(gb0 + ko);
      if (WNT == 4) rb1 = *(const u32x4*)(gb1 + ko);
    }
    bf16x8 af[8], bfr[WNT];
#pragma unroll
    for (int mt = 0; mt < 8; ++mt) af[mt] = *(const bf16x8*)(cur + aoff + mt * 1024);
#pragma unroll
    for (int nt = 0; nt < WNT; ++nt) bfr[nt] = *(const bf16x8*)(cur + boff + nt * 1024);
#pragma unroll
    for (int mt = 0; mt < 8; ++mt)
#pragma unroll
      for (int nt = 0; nt < WNT; ++nt) acc[mt][nt] = mfma16(bfr[nt], af[mt], acc[mt][nt]);
    if (more) {
      *(u32x4*)(nxt + soff) = ra0; *(u32x4*)(nxt + soff + 128 * 64) = ra1;
      *(u32x4*)(nxt + 16384 + soff) = rb0;
      if (WNT == 4) *(u32x4*)(nxt + 16384 + soff + 128 * 64) = rb1;
    }
    __syncthreads();
  }
}

template <int WNT>
DI void zero_acc(f32x4 (&acc)[8][WNT]) {
#pragma unroll
  for (int mt = 0; mt < 8; ++mt)
#pragma unroll
    for (int nt = 0; nt < WNT; ++nt) acc[mt][nt] = (f32x4){0.f, 0.f, 0.f, 0.f};
}

DI void transpose_item(const float* __restrict__ W, int K, int N, bf16_t* __restrict__ WT, int row_off, float* scr, int item, int lane, bool rope_perm = false) {
  const int nblk = N / 32, kb = item / nblk, nb = item % nblk, k0 = 64 * kb, n0 = 32 * nb;
#pragma unroll 8
  for (int i = 0; i < 32; ++i) { const int kk = 2 * i + (lane >> 5); scr[kk * 33 + (lane & 31)] = W[(size_t)(k0 + kk) * N + n0 + (lane & 31)]; }
  asm volatile("s_waitcnt lgkmcnt(0)" ::: "memory");
  const int c = lane & 7;
#pragma unroll
  for (int j = 0; j < 4; ++j) {
    const int n = (lane >> 3) + 8 * j; const float* s = scr + (8 * c) * 33 + n;
    u32x4 o; o.x = cvtpk(s[0 * 33], s[1 * 33]); o.y = cvtpk(s[2 * 33], s[3 * 33]); o.z = cvtpk(s[4 * 33], s[5 * 33]); o.w = cvtpk(s[6 * 33], s[7 * 33]);
    const int nn = rope_perm ? ((n < 16) ? 8 * (n >> 2) + (n & 3) : 8 * ((n - 16) >> 2) + 4 + (n & 3)) : n;
    *(u32x4*)(WT + (size_t)(row_off + n0 + nn) * K + k0 + 8 * c) = o;
  }
  asm volatile("s_waitcnt lgkmcnt(0)" ::: "memory");
}

DI void convert_weights(const Params& p, int l, char* lds, int vcu, int G) {
  const int tid = opaque_tid(), lane = tid & 63, wave = tid >> 6, gw = vcu * 8 + wave, ngw = G * 8;
  float* scr = (float*)(lds + wave * 8704);
  unsigned char* wsw = p.ws + WS_W;
  constexpr int I_IN = (DM / 64) * (INW / 32), I_BR = (512 / 64) * (DM / 32), I_OUT = (DM / 64) * (DM / 32), I_G = (DM / 64) * (DFF / 32), I_D = (DFF / 64) * (DM / 32);
  constexpr int NITEMS = I_IN + 3 * I_BR + I_OUT + 2 * I_G + I_D;
  for (int it = gw; it < NITEMS; it += ngw) {
    int r = it;
    if (r < I_IN) { const int c0 = 32 * (r % (INW / 32)); const bool rp = (c0 >= COL_BQ && c0 < COL_BV) || (c0 >= COL_CQ && c0 < COL_CV);
      transpose_item(p.w_in + (size_t)l * DM * INW, DM, INW, (bf16_t*)(wsw + W_IN), 0, scr, r, lane, rp); continue; } r -= I_IN;
    if (r < 3 * I_BR) { const int i = r / I_BR; transpose_item(p.w_branch + ((size_t)l * 3 + i) * 512 * DM, 512, DM, (bf16_t*)(wsw + W_BR) + (size_t)i * DM * 512, 0, scr, r % I_BR, lane); continue; } r -= 3 * I_BR;
    if (r < I_OUT) { transpose_item(p.w_out + (size_t)l * DM * DM, DM, DM, (bf16_t*)(wsw + W_OUT), 0, scr, r, lane); continue; } r -= I_OUT;
    if (r < I_G) { transpose_item(p.w_gate + (size_t)l * DM * DFF, DM, DFF, (bf16_t*)(wsw + W_GU), 0, scr, r, lane); continue; } r -= I_G;
    if (r < I_G) { transpose_item(p.w_up + (size_t)l * DM * DFF, DM, DFF, (bf16_t*)(wsw + W_GU), DFF, scr, r, lane); continue; } r -= I_G;
    transpose_item(p.w_down + (size_t)l * DFF * DM, DFF, DM, (bf16_t*)(wsw + W_DN), 0, scr, r, lane);
  }
}

DI void ada_phase(const Params& p, char* lds, int vcu, int G) {
  const int tid = opaque_tid();
  float* sv = (float*)lds;
  float* red = (float*)(lds + 9 * 1024 * 4);
  float* mod = (float*)(p.ws + WS_MOD);
  bool have = false;
  for (int u = vcu; u < DEPTH * 48; u += G) {
    if (!have) {
      for (int e = tid; e < 9 * 1024; e += 512) { const int i = e >> 10, k = e & 1023; const float v = (i < 8) ? p.c[i * 1024 + k] : p.c_ctx[k]; sv[e] = v / (1.0f + __expf(-v)); }
      have = true;
    }
    __syncthreads();
    const int l = u / 48, nb = u % 48, col = tid & 127, kg = tid >> 7;
    const float* w = p.w_ada + (size_t)l * DM * 6144 + nb * 128 + col;
    float a[9];
#pragma unroll
    for (int i = 0; i < 9; ++i) a[i] = 0.f;
#pragma unroll 8
    for (int k = kg * 256; k < kg * 256 + 256; ++k) {
      const float wv = w[(size_t)k * 6144];
#pragma unroll
      for (int i = 0; i < 9; ++i) a[i] += sv[i * 1024 + k] * wv;
    }
#pragma unroll
    for (int i = 0; i < 9; ++i) red[(kg * 9 + i) * 128 + col] = a[i];
    __syncthreads();
    for (int e = tid; e < 9 * 128; e += 512) {
      const int i = e >> 7, cc = e & 127;
      const float s = red[(0 * 9 + i) * 128 + cc] + red[(1 * 9 + i) * 128 + cc] + red[(2 * 9 + i) * 128 + cc] + red[(3 * 9 + i) * 128 + cc];
      mod[((size_t)l * 9 + i) * 6144 + nb * 128 + cc] = s + p.b_ada[l * 6144 + nb * 128 + cc];
    }
    __syncthreads();
  }
  __syncthreads();
}

DI void norm_phase(const Params& p, int l, int which, const float* lat_src, const float* ctx_src, int vcu, int G, int nrows) {
  const int tid = opaque_tid(), lane = tid & 63, gw = vcu * 8 + (tid >> 6), ngw = G * 8;
  bf16_t* H = (bf16_t*)(p.ws + WS_H);
  const float* mod = (const float*)(p.ws + WS_MOD);
  const float* g = (which ? p.norm2_g : p.norm1_g) + l * DM;
  const int rpw = (nrows + ngw - 1) / ngw;
  const int r0 = gw * rpw, r1 = (r0 + rpw < nrows) ? r0 + rpw : nrows;
  if (r0 >= r1) return;
  f32x4 gs[4], sh4[4];
  int cur_mi = -1;
  f32x4 nv[4];
  {
    const float* xr0 = (r0 < NLAT) ? lat_src + (size_t)r0 * DM : ctx_src + (size_t)(r0 - NLAT) * DM;
#pragma unroll
    for (int j = 0; j < 4; ++j) nv[j] = ((const f32x4*)xr0)[lane + 64 * j];
  }
  for (int row = r0; row < r1; ++row) {
    const int mi = (row < NLAT) ? (row >> 12) : 8;
    if (mi != cur_mi) {
      const float* sh = mod + ((size_t)(l * 9 + mi) * 6 + (which ? 3 : 0)) * DM;
      const float* sc = sh + DM;
#pragma unroll
      for (int j = 0; j < 4; ++j) {
        const f32x4 gg = ((const f32x4*)g)[lane + 64 * j], s1 = ((const f32x4*)sc)[lane + 64 * j];
        gs[j] = gg * (s1 + 1.0f); sh4[j] = ((const f32x4*)sh)[lane + 64 * j];
      }
      cur_mi = mi;
    }
    f32x4 v[4]; float ss = 0.f;
#pragma unroll
    for (int j = 0; j < 4; ++j) v[j] = nv[j];
    const int nr = row + 1;
    if (nr < r1) {
      const float* xn = (nr < NLAT) ? lat_src + (size_t)nr * DM : ctx_src + (size_t)(nr - NLAT) * DM;
#pragma unroll
      for (int j = 0; j < 4; ++j) nv[j] = ((const f32x4*)xn)[lane + 64 * j];
    }
#pragma unroll
    for (int j = 0; j < 4; ++j) ss += (v[j].x * v[j].x + v[j].y * v[j].y) + (v[j].z * v[j].z + v[j].w * v[j].w);
    const float rstd = 1.0f / sqrtf(wave_sum(ss) * (1.0f / DM) + EPS);
    u32x2* o = (u32x2*)(H + (size_t)row * DM);
#pragma unroll
    for (int j = 0; j < 4; ++j) {
      const f32x4 y = (v[j] * rstd) * gs[j] + sh4[j];
      u32x2 w; w.x = cvtpk(y.x, y.y); w.y = cvtpk(y.z, y.w);
      o[lane + 64 * j] = w;
    }
  }
}

DI int half_grow(int hb, int lrow) { return (lrow < HALF_LAT) ? hb * HALF_LAT + lrow : NLAT + hb * HALF_CTX + (lrow - HALF_LAT); }

DI void gemm1_phase(const Params& p, int hb, char* lds, int vcu, int G) {
  const int tid = opaque_tid(), lane = tid & 63, wave = tid >> 6, wm = wave >> 2, wn = wave & 3, r16 = lane & 15, quad = lane >> 4;
  const bf16_t* H = (const bf16_t*)(p.ws + WS_H);
  const bf16_t* Wt = (const bf16_t*)(p.ws + WS_W + W_IN);
  bf16_t* P = (bf16_t*)(p.ws + WS_R + R_P);
  const float* ropec = (const float*)(p.ws + WS_ROPE);
  const float* ropes = ropec + 1024;
  constexpr int NT = INW / 256, MT = MH / 256;
  for (int u = vcu; u < MT * NT; u += G) {
    const int tm = u / NT, tn = u % NT;
    const int lrow0 = tm * 256, grow0 = half_grow(hb, lrow0), n0 = tn * 256;
    f32x4 acc[8][4]; zero_acc<4>(acc);
    gemm_core<4>(acc, H + (size_t)grow0 * DM, DM, Wt + (size_t)n0 * DM, DM, DM, lds);
    const int cb = n0 + wn * 64;
    const bool latent = lrow0 < HALF_LAT;
    int kind = 0;
    if (cb < COL_BQ) kind = 1;
    else if (cb < COL_BV || (cb >= COL_CQ && cb < COL_CV)) kind = latent ? 2 : 0;
    else if (cb >= COL_G) kind = 3;
    const bool qscale = (cb >= COL_BQ && cb < COL_BK) || (cb >= COL_CQ && cb < COL_CK);
#pragma unroll
    for (int mt = 0; mt < 8; ++mt) {
      const int lr = lrow0 + wm * 128 + mt * 16 + r16;
      if (kind == 1) {
#pragma unroll
        for (int nt = 0; nt < 4; ++nt)
#pragma unroll
          for (int j = 0; j < 4; ++j) acc[mt][nt][j] = gelu_tanh(acc[mt][nt][j]);
      } else if (kind == 3) {
#pragma unroll
        for (int nt = 0; nt < 4; ++nt)
#pragma unroll
          for (int j = 0; j < 4; ++j) acc[mt][nt][j] = sigmoidf_(acc[mt][nt][j]);
      } else if (kind == 2) {
        const int t = lr & (SEQ - 1);
        const int pr = t >> 6, pc = t & 63;
        const f32x4 cr = *(const f32x4*)(ropec + pr * 16 + quad * 4), sr = *(const f32x4*)(ropes + pr * 16 + quad * 4);
        const f32x4 cc = *(const f32x4*)(ropec + pc * 16 + quad * 4), sc = *(const f32x4*)(ropes + pc * 16 + quad * 4);
        const f32x4 a1 = acc[mt][0], a2 = acc[mt][1], b1 = acc[mt][2], b2 = acc[mt][3];
        acc[mt][0] = a1 * cr - a2 * sr; acc[mt][1] = a2 * cr + a1 * sr;
        acc[mt][2] = b1 * cc - b2 * sc; acc[mt][3] = b2 * cc + b1 * sc;
      }
      if (qscale) {
#pragma unroll
        for (int nt = 0; nt < 4; ++nt) acc[mt][nt] = acc[mt][nt] * SM_C;
      }
      bf16_t* orow = P + (size_t)lr * LDP + cb + quad * 4;
#pragma unroll
      for (int nt = 0; nt < 4; ++nt) { u32x2 w; w.x = cvtpk(acc[mt][nt][0], acc[mt][nt][1]); w.y = cvtpk(acc[mt][nt][2], acc[mt][nt][3]); *(u32x2*)(orow + nt * 16) = w; }
    }
  }
}

DI void merge_phase(const Params& p, int hb, char* lds, int vcu, int G, int mtiles) {
  const int tid = opaque_tid(), lane = tid & 63, wave = tid >> 6, wm = wave >> 2, wn = wave & 3, r16 = lane & 15, quad = lane >> 4;
  const bf16_t* P = (const bf16_t*)(p.ws + WS_R + R_P);
  const bf16_t* Wb = (const bf16_t*)(p.ws + WS_W + W_BR);
  bf16_t* Y = (bf16_t*)(p.ws + WS_R + R_Y);
  constexpr int NT = DM / 128;
  for (int u = vcu; u < mtiles * NT; u += G) {
    const int tm = u / NT, tn = u % NT;
    const int lrow0 = tm * 256, grow0 = half_grow(hb, lrow0), n0 = tn * 128;
    f32x4 y[8][2]; zero_acc<2>(y);
#pragma unroll 1
    for (int i = 0; i < 3; ++i) {
      const int ocol = (i == 0) ? COL_AU : (i == 1 ? COL_BQ : COL_CQ);
      f32x4 acc[8][2]; zero_acc<2>(acc);
      gemm_core<2>(acc, P + (size_t)lrow0 * LDP + ocol, LDP, Wb + ((size_t)i * DM + n0) * 512, 512, 512, lds);
#pragma unroll
      for (int mt = 0; mt < 8; ++mt) {
        const int lr = lrow0 + wm * 128 + mt * 16 + r16;
        const bf16_t* gp = P + (size_t)lr * LDP + COL_G + i * DM + n0 + wn * 32 + quad * 4;
#pragma unroll
        for (int nt = 0; nt < 2; ++nt) {
          const u32x2 gw = *(const u32x2*)(gp + nt * 16);
          y[mt][nt][0] += bf_lo(gw.x) * acc[mt][nt][0]; y[mt][nt][1] += bf_hi(gw.x) * acc[mt][nt][1];
          y[mt][nt][2] += bf_lo(gw.y) * acc[mt][nt][2]; y[mt][nt][3] += bf_hi(gw.y) * acc[mt][nt][3];
        }
      }
    }
#pragma unroll
    for (int mt = 0; mt < 8; ++mt) {
      const int gr = grow0 + wm * 128 + mt * 16 + r16;
      bf16_t* orow = Y + (size_t)gr * DM + n0 + wn * 32 + quad * 4;
#pragma unroll
      for (int nt = 0; nt < 2; ++nt) { u32x2 w; w.x = cvtpk(y[mt][nt][0], y[mt][nt][1]); w.y = cvtpk(y[mt][nt][2], y[mt][nt][3]); *(u32x2*)(orow + nt * 16) = w; }
    }
  }
}

DI void resid_gemm_phase(const Params& p, int l, const bf16_t* A, int lda, const bf16_t* Wt, int K, int gidx,
                         const float* lat_src, const float* ctx_src, float* lat_dst, float* ctx_dst, char* lds, int vcu, int G) {
  const int tid = opaque_tid(), lane = tid & 63, wave = tid >> 6, wm = wave >> 2, wn = wave & 3, r16 = lane & 15, quad = lane >> 4;
  const float* mod = (const float*)(p.ws + WS_MOD);
  constexpr int NT = DM / 256, MT = MTOT / 256;
  for (int u = vcu; u < MT * NT; u += G) {
    const int tm = u / NT, tn = u % NT;
    const int grow0 = tm * 256, n0 = tn * 256;
    f32x4 acc[8][4]; zero_acc<4>(acc);
    gemm_core<4>(acc, A + (size_t)grow0 * lda, lda, Wt + (size_t)n0 * K, K, K, lds);
    const bool latent = grow0 < NLAT;
    const int mi = latent ? (grow0 >> 12) : 8;
    const float* gv = mod + ((size_t)(l * 9 + mi) * 6 + gidx) * DM + n0 + wn * 64 + quad * 4;
    f32x4 gg[4];
#pragma unroll
    for (int nt = 0; nt < 4; ++nt) gg[nt] = *(const f32x4*)(gv + nt * 16);
#pragma unroll
    for (int mt = 0; mt < 8; ++mt) {
      const int gr = grow0 + wm * 128 + mt * 16 + r16;
      const size_t off = (latent ? (size_t)gr * DM : (size_t)(gr - NLAT) * DM) + n0 + wn * 64 + quad * 4;
      const float* src = (latent ? lat_src : ctx_src) + off;
      float* dst = (latent ? lat_dst : ctx_dst) + off;
#pragma unroll
      for (int nt = 0; nt < 4; ++nt) { const f32x4 r = *(const f32x4*)(src + nt * 16); *(f32x4*)(dst + nt * 16) = r + gg[nt] * acc[mt][nt]; }
    }
  }
}

DI void gateup_phase(const Params& p, char* lds, int vcu, int G) {
  const int tid = opaque_tid(), lane = tid & 63, wave = tid >> 6, wm = wave >> 2, wn = wave & 3, r16 = lane & 15, quad = lane >> 4;
  const bf16_t* H = (const bf16_t*)(p.ws + WS_H);
  const bf16_t* Wt = (const bf16_t*)(p.ws + WS_W + W_GU);
  bf16_t* Ab = (bf16_t*)(p.ws + WS_R + R_A);
  bf16_t* Ub = (bf16_t*)(p.ws + WS_R + R_UP);
  constexpr int NT = 2 * DFF / 256, MT = MTOT / 256;
  for (int u = vcu; u < MT * NT; u += G) {
    const int tm = u / NT, tn = u % NT;
    const int grow0 = tm * 256, n0 = tn * 256;
    f32x4 acc[8][4]; zero_acc<4>(acc);
    gemm_core<4>(acc, H + (size_t)grow0 * DM, DM, Wt + (size_t)n0 * DM, DM, DM, lds);
    bf16_t* O = (n0 < DFF) ? Ab + n0 : Ub + (n0 - DFF);
#pragma unroll
    for (int mt = 0; mt < 8; ++mt) {
      const int gr = grow0 + wm * 128 + mt * 16 + r16;
      bf16_t* orow = O + (size_t)gr * DFF + wn * 64 + quad * 4;
#pragma unroll
      for (int nt = 0; nt < 4; ++nt) { u32x2 w; w.x = cvtpk(acc[mt][nt][0], acc[mt][nt][1]); w.y = cvtpk(acc[mt][nt][2], acc[mt][nt][3]); *(u32x2*)(orow + nt * 16) = w; }
    }
  }
}

DI void conv_phase(const Params& p, int l, int vcu, int G, int nrows) {
  const int tid = opaque_tid();
  const bf16_t* Ab = (const bf16_t*)(p.ws + WS_R + R_A);
  bf16_t* Ub = (bf16_t*)(p.ws + WS_R + R_UP);
  if (tid >= DFF / 8) return;
  const int cc = tid * 8;
  const float* cw = p.conv_w + (size_t)l * 3 * DFF + cc;
  const float* cb = p.conv_b + (size_t)l * DFF + cc;
  float w0[8], w1[8], w2[8], bb[8];
#pragma unroll
  for (int j = 0; j < 2; ++j) {
    const f32x4 a = *(const f32x4*)(cw + 4 * j), b = *(const f32x4*)(cw + DFF + 4 * j), c = *(const f32x4*)(cw + 2 * DFF + 4 * j), d = *(const f32x4*)(cb + 4 * j);
#pragma unroll
    for (int i = 0; i < 4; ++i) { w0[4 * j + i] = a[i]; w1[4 * j + i] = b[i]; w2[4 * j + i] = c[i]; bb[4 * j + i] = d[i]; }
  }
  const int rpb = (nrows + G - 1) / G;
  const int r0 = vcu * rpb, r1 = (r0 + rpb < nrows) ? r0 + rpb : nrows;
  const u32x4 zero = {0u, 0u, 0u, 0u};
  auto seq_first = [](int row) -> bool { return row < NLAT ? (row & (SEQ - 1)) == 0 : ((row - NLAT) & (NCTX - 1)) == 0; };
  auto seq_last = [](int row) -> bool { return row < NLAT ? (row & (SEQ - 1)) == SEQ - 1 : ((row - NLAT) & (NCTX - 1)) == NCTX - 1; };
  if (r0 >= r1) return;
  u32x4 aprev = seq_first(r0) ? zero : *(const u32x4*)(Ab + (size_t)(r0 - 1) * DFF + cc);
  u32x4 acur = *(const u32x4*)(Ab + (size_t)r0 * DFF + cc);
  for (int row = r0; row < r1; row += 4) {
    u32x4 an[4], uu[4];
#pragma unroll
    for (int i = 0; i < 4; ++i) {
      const int rr = row + i;
      an[i] = zero; uu[i] = zero;
      if (rr < r1) {
        an[i] = *(const u32x4*)(Ab + (size_t)(rr + 1) * DFF + cc);
        uu[i] = *(const u32x4*)(Ub + (size_t)rr * DFF + cc);
      }
    }
#pragma unroll
    for (int i = 0; i < 4; ++i) {
      const int rr = row + i;
      if (rr < r1) {
        const u32x4 ap = seq_first(rr) ? zero : aprev;
        const u32x4 ax = seq_last(rr) ? zero : an[i];
        u32x4 o;
#pragma unroll
        for (int j = 0; j < 4; ++j) {
          const float v0 = w0[2 * j] * bf_lo(ap[j]) + w1[2 * j] * bf_lo(acur[j]) + w2[2 * j] * bf_lo(ax[j]) + bb[2 * j];
          const float v1 = w0[2 * j + 1] * bf_hi(ap[j]) + w1[2 * j + 1] * bf_hi(acur[j]) + w2[2 * j + 1] * bf_hi(ax[j]) + bb[2 * j + 1];
          o[j] = cvtpk(siluf_(v0) * bf_lo(uu[i][j]), siluf_(v1) * bf_hi(uu[i][j]));
        }
        *(u32x4*)(Ub + (size_t)rr * DFF + cc) = o;
        aprev = acur; acur = an[i];
      }
    }
  }
}

namespace pg8 {
#define PG8_LAS __attribute__((address_space(3)))
typedef unsigned short bf16_t;
typedef short bf16x8 __attribute__((ext_vector_type(8)));
typedef float f32x4 __attribute__((ext_vector_type(4)));
typedef unsigned u32x4 __attribute__((ext_vector_type(4)));
constexpr int BM = 256, BK = 64, HALF = 128, HTB = HALF * BK * 2  , STAGE_BYTES = 8 * HTB, NXCD = 8, WGM = 8;

__host__ __device__ __forceinline__ int lds_byte(int r, int c) { const int st = (r >> 4) * 2 + (c >> 5), rr = r & 15, cc = c & 31, ob = rr * 64 + cc * 2; return st * 1024 + (ob ^ (((ob >> 9) & 1) << 5)); }
__host__ __device__ __forceinline__ void stage_rc(int b, int& R, int& C) { const int st = b / 1024, sb = b % 1024, swz = sb ^ (((sb >> 9) & 1) << 5); R = (st >> 1) * 16 + swz / 64; C = (st & 1) * 32 + (swz % 64) / 2; }
__host__ __device__ __forceinline__ int perm32(int rho) { const int n = rho >> 4, i = rho & 15; return 8 * (i >> 2) + 4 * n + (i & 3); }

struct Unit { int pm, pn; const char* A; const char* B; int nt; int flags; };
struct Gemm { int lda, ldb; };
template <class Epi, class Sched, bool ALIGN_EPI = false, bool SP2 = false>
__device__ __forceinline__ void gemm_phase(PG8_LAS unsigned char* lds, const Gemm g, const Sched& S, const Epi& E) {
    const int tid = opaque_tid(), wid = __builtin_amdgcn_readfirstlane(tid >> 6), lane = tid & 63, wr = wid >> 2, wc = wid & 3, fr = lane & 15, fq = lane >> 4;
    const int lda = g.lda, ldb = g.ldb;
    unsigned voffA[2], voffB[2];
#pragma unroll
    for (int i = 0; i < 2; ++i) { int R, C; stage_rc(tid * 16 + i * 8192, R, C); const int Rb = Epi::PERM ? ((R & ~31) + perm32(R & 31)) : R;
        voffA[i] = (unsigned)(R * lda + C) * 2u; voffB[i] = (unsigned)(Rb * ldb + C) * 2u; }
    const size_t kstep = (size_t)(BK * 2);
    const size_t hstepA = (size_t)HALF * lda * 2, hstepB = (size_t)HALF * ldb * 2;
    const unsigned ldsw = (unsigned)wid * 1024u;
    const int aoff = lds_byte(wr * 64 + fr, fq * 8), boff = lds_byte(wc * 32 + fr, fq * 8);
#define PG8_SA(b, h) (((b) * 2 + (h)) * HTB)
#define PG8_SB(b, h) ((4 + (b) * 2 + (h)) * HTB)
#define PG8_STAGE(bufoff, gbase, voff) do { _Pragma("unroll") for (int _i = 0; _i < 2; ++_i) \
        __builtin_amdgcn_global_load_lds((const unsigned*)((const char*)(gbase) + (voff)[_i]), (PG8_LAS unsigned*)(lds + (bufoff) + ldsw + _i * 8192), 16, 0, 0); } while (0)
#define PG8_LDA(dst, b, h) do { _Pragma("unroll") for (int m = 0; m < 4; ++m) _Pragma("unroll") for (int k = 0; k < 2; ++k) dst[m][k] = *(const PG8_LAS bf16x8*)(lds + PG8_SA(b, h) + aoff + m * 2048 + k * 1024); } while (0)
#define PG8_LDB(dst, b, h) do { _Pragma("unroll") for (int n = 0; n < 2; ++n) _Pragma("unroll") for (int k = 0; k < 2; ++k) dst[n][k] = *(const PG8_LAS bf16x8*)(lds + PG8_SB(b, h) + boff + n * 2048 + k * 1024); } while (0)
#define PG8_MMA(ai, bj, At, Bt) do { __builtin_amdgcn_s_setprio(1); _Pragma("unroll") for (int m = 0; m < 4; ++m) _Pragma("unroll") for (int n = 0; n < 2; ++n) _Pragma("unroll") for (int k = 0; k < 2; ++k) \
        acc[ai][bj][m][n] = __builtin_amdgcn_mfma_f32_16x16x32_bf16(Bt[n][k], At[m][k], acc[ai][bj][m][n], 0, 0, 0); __builtin_amdgcn_s_setprio(0); } while (0)
#define PG8_WAIT_V(n) asm volatile("s_waitcnt vmcnt(" #n ")" ::: "memory")
#define PG8_WAIT_L(n) asm volatile("s_waitcnt lgkmcnt(" #n ")" ::: "memory")
#define PG8_BAR __builtin_amdgcn_s_barrier()
#define PG8_SCHED __builtin_amdgcn_sched_barrier(0)
    Unit cur, nxt; int ui = 0;
    if (!S.next(0, cur)) return;
    f32x4 acc[2][2][4][2];
#pragma unroll
    for (int a = 0; a < 2; ++a)
#pragma unroll
        for (int b = 0; b < 2; ++b)
#pragma unroll
            for (int m = 0; m < 4; ++m)
#pragma unroll
                for (int n = 0; n < 2; ++n) acc[a][b][m][n] = (f32x4){0.f, 0.f, 0.f, 0.f};
    bf16x8 At[4][2], B0[2][2], B1[2][2];
    const char* cA = cur.A; const char* cB = cur.B;
    S.a_ready(cur);
    if constexpr (SP2) {
        PG8_STAGE(PG8_SB(0, 0), cB, voffB); PG8_STAGE(PG8_SB(0, 1), cB + hstepB, voffB); PG8_STAGE(PG8_SA(0, 0), cA, voffA); PG8_STAGE(PG8_SA(0, 1), cA + hstepA, voffA);
        if (wr == 1) PG8_BAR;
        PG8_WAIT_V(2); PG8_BAR;
        PG8_STAGE(PG8_SB(1, 0), cB + kstep, voffB); PG8_STAGE(PG8_SA(1, 0), cA + kstep, voffA); PG8_STAGE(PG8_SB(1, 1), cB + hstepB + kstep, voffB);
        PG8_WAIT_V(6); PG8_BAR;
    } else {
        PG8_STAGE(PG8_SB(0, 0), cB, voffB); PG8_STAGE(PG8_SA(0, 0), cA, voffA); PG8_STAGE(PG8_SB(0, 1), cB + hstepB, voffB); PG8_STAGE(PG8_SA(0, 1), cA + hstepA, voffA);
        if (wr == 1) PG8_BAR;
        PG8_WAIT_V(4); PG8_BAR;
        PG8_STAGE(PG8_SB(1, 0), cB + kstep, voffB); PG8_STAGE(PG8_SA(1, 0), cA + kstep, voffA); PG8_STAGE(PG8_SB(1, 1), cB + hstepB + kstep, voffB);
        PG8_WAIT_V(6); PG8_BAR;
    }
    for (;;) {
        const bool has_next = S.next(ui + 1, nxt);
        const char* nA = has_next ? nxt.A : cA; const char* nB = has_next ? nxt.B : cB;
        const int nt = cur.nt;
        for (int t = 0; t < nt; t += 2) {
            const bool last = (t == nt - 2);
            const char* a1 = cA + (size_t)(t + 1) * kstep;
            const char* a2 = last ? nA : cA + (size_t)(t + 2) * kstep; const char* b2 = last ? nB : cB + (size_t)(t + 2) * kstep;
            const char* a3 = a2 + kstep; const char* b3 = b2 + kstep;
            if (last && has_next) S.a_ready(nxt);
            if constexpr (SP2) {
            PG8_LDB(B0, 0, 0); PG8_LDB(B1, 0, 1); PG8_SCHED; PG8_LDA(At, 0, 0); PG8_STAGE(PG8_SA(1, 1), a1 + hstepA, voffA);
            PG8_WAIT_V(8); PG8_WAIT_L(0); PG8_BAR; PG8_MMA(0, 0, At, B0); PG8_MMA(0, 1, At, B1); PG8_BAR; PG8_SCHED;
            PG8_LDA(At, 0, 1); PG8_STAGE(PG8_SB(0, 0), b2, voffB); PG8_STAGE(PG8_SB(0, 1), b2 + hstepB, voffB); PG8_STAGE(PG8_SA(0, 0), a2, voffA);
            PG8_WAIT_V(8); PG8_WAIT_L(0); PG8_BAR; PG8_MMA(1, 0, At, B0); PG8_MMA(1, 1, At, B1); PG8_BAR; PG8_SCHED;
            PG8_LDB(B0, 1, 0); PG8_LDB(B1, 1, 1); PG8_SCHED; PG8_LDA(At, 1, 0); PG8_STAGE(PG8_SA(0, 1), a2 + hstepA, voffA);
            PG8_WAIT_V(8); PG8_WAIT_L(0); PG8_BAR; PG8_MMA(0, 0, At, B0); PG8_MMA(0, 1, At, B1); PG8_BAR; PG8_SCHED;
            PG8_LDA(At, 1, 1); PG8_STAGE(PG8_SB(1, 0), b3, voffB); PG8_STAGE(PG8_SB(1, 1), b3 + hstepB, voffB); PG8_STAGE(PG8_SA(1, 0), a3, voffA);
            PG8_WAIT_V(8); PG8_WAIT_L(0); PG8_BAR; PG8_MMA(1, 0, At, B0); PG8_MMA(1, 1, At, B1); PG8_BAR; PG8_SCHED;
            } else {
            PG8_LDB(B0, 0, 0); PG8_SCHED; PG8_LDA(At, 0, 0); PG8_STAGE(PG8_SA(1, 1), a1 + hstepA, voffA);
            PG8_WAIT_L(8); PG8_BAR; PG8_WAIT_L(0); PG8_MMA(0, 0, At, B0); PG8_BAR; PG8_SCHED;
            PG8_LDB(B1, 0, 1); PG8_STAGE(PG8_SB(0, 0), b2, voffB);
            PG8_BAR; PG8_WAIT_L(0); PG8_MMA(0, 1, At, B1); PG8_BAR;
            PG8_LDA(At, 0, 1); PG8_STAGE(PG8_SA(0, 0), a2, voffA);
            PG8_BAR; PG8_WAIT_L(0); PG8_MMA(1, 0, At, B0); PG8_BAR; PG8_SCHED;
            PG8_STAGE(PG8_SB(0, 1), b2 + hstepB, voffB);
            PG8_WAIT_V(6); PG8_BAR; PG8_MMA(1, 1, At, B1); PG8_BAR;
            PG8_LDB(B0, 1, 0); PG8_SCHED; PG8_LDA(At, 1, 0); PG8_STAGE(PG8_SA(0, 1), a2 + hstepA, voffA);
            PG8_WAIT_L(8); PG8_BAR; PG8_WAIT_L(0); PG8_MMA(0, 0, At, B0); PG8_BAR; PG8_SCHED;
            PG8_LDB(B1, 1, 1); PG8_STAGE(PG8_SB(1, 0), b3, voffB);
            PG8_BAR; PG8_WAIT_L(0); PG8_MMA(0, 1, At, B1); PG8_BAR;
            PG8_LDA(At, 1, 1); PG8_STAGE(PG8_SA(1, 0), a3, voffA);
            PG8_BAR; PG8_WAIT_L(0); PG8_MMA(1, 0, At, B0); PG8_BAR; PG8_SCHED;
            PG8_STAGE(PG8_SB(1, 1), b3 + hstepB, voffB);
            PG8_WAIT_V(6); PG8_BAR; PG8_MMA(1, 1, At, B1); PG8_BAR;
            }
        }
        if constexpr (ALIGN_EPI) { if (wr == 0) PG8_BAR; }
        if constexpr (!Epi::AFTER_DRAIN) { E(acc, cur, wr, wc, fr, fq); S.done(cur); }
        if (!has_next) break;
        if (!(cur.flags & 1))
#pragma unroll
        for (int a = 0; a < 2; ++a)
#pragma unroll
            for (int b = 0; b < 2; ++b)
#pragma unroll
                for (int m = 0; m < 4; ++m)
#pragma unroll
                    for (int n = 0; n < 2; ++n) acc[a][b][m][n] = (f32x4){0.f, 0.f, 0.f, 0.f};
        cur = nxt; cA = nA; cB = nB; ++ui;
        if constexpr (ALIGN_EPI) { if (wr == 1) PG8_BAR; }
    }
    PG8_WAIT_V(0);
    if constexpr (!ALIGN_EPI) { if (wr == 0) PG8_BAR; }
    PG8_BAR;
    if constexpr (Epi::AFTER_DRAIN) { E.fused(acc, cur, wr, wc, fr, fq, lds, wid, lane); S.done(cur); }
#undef PG8_SA
#undef PG8_SB
#undef PG8_STAGE
#undef PG8_LDA
#undef PG8_LDB
#undef PG8_MMA
#undef PG8_WAIT_V
#undef PG8_WAIT_L
#undef PG8_BAR
#undef PG8_SCHED
}
}
namespace pg8 {
struct TileOrder {
  const char* A; const char* B; size_t tstepA, tstepB; int ntK;
  int nN, ntiles, G, c, hb;
  __device__ __forceinline__ bool next(int i, Unit& u) const {
    const int L = i * G + c; if (L >= ntiles) return false;
    const int gsz = 4 * nN, gi = L / gsz, w = L - gi * gsz;
    const int lt = gi * 4 + (w & 3); u.pn = w >> 2;
    u.pm = (hb < 0) ? lt : ((lt < 64) ? hb * 64 + lt : 128 + hb * 4 + (lt - 64));
    u.A = A + (size_t)u.pm * tstepA; u.B = B + (size_t)u.pn * tstepB; u.nt = ntK; u.flags = 0;
    return true;
  }
  __device__ __forceinline__ void a_ready(const Unit&) const {}
  __device__ __forceinline__ void done(const Unit&) const {}
};
struct ResidOrder {
  const char* A; const char* B; size_t tstepA, tstepB; int ntK;
  int nunits, G, c;
  __device__ __forceinline__ bool next(int i, Unit& u) const {
    const int L = i * G + c; if (L >= nunits) return false;
    int k0 = 0;
    if (L < 512) { u.pm = L >> 2; u.pn = L & 3; }
    else { const int tile = L - 512; u.pm = 128 + (tile >> 2); u.pn = tile & 3; }
    u.nt = ntK; u.flags = 0;
    u.A = A + (size_t)u.pm * tstepA + (size_t)k0 * (BK * 2); u.B = B + (size_t)u.pn * tstepB + (size_t)k0 * (BK * 2);
    return true;
  }
  __device__ __forceinline__ void a_ready(const Unit&) const {}
  __device__ __forceinline__ void done(const Unit&) const {}
};
struct MergeOrder {
  const char* P; const char* Wb; int ntiles, G, c;
  __device__ __forceinline__ bool next(int i, Unit& u) const {
    const int rnd = i / 3, br = i - 3 * rnd;
    const int T = rnd * G + c; if (T >= ntiles) return false;
    const int lt = (T < 256) ? (T >> 2) : 64 + ((T - 256) >> 2);
    u.pm = lt; u.pn = T & 3;
    const int ocol = (br == 0) ? COL_AU : (br == 1 ? COL_BQ : COL_CQ);
    u.A = P + ((size_t)lt * 256 * LDP + ocol) * 2; u.B = Wb + ((size_t)br * DM + u.pn * 256) * 512 * 2;
    u.nt = 512 / BK; u.flags = (br < 2 ? 1 : 0) | (br << 4);
    return true;
  }
  __device__ __forceinline__ void a_ready(const Unit&) const {}
  __device__ __forceinline__ void done(const Unit&) const {}
};
struct EpiMerge {
  static constexpr bool PERM = true, AFTER_DRAIN = false;
  const ::bf16_t* P; ::bf16_t* Y; int hb;
  __device__ __forceinline__ void operator()(f32x4 (&acc)[2][2][4][2], const Unit& u, int wr, int wc, int fr, int fq) const {
    const int br = u.flags >> 4;
#pragma unroll
    for (int ai = 0; ai < 2; ++ai)
#pragma unroll
      for (int m = 0; m < 4; ++m) {
        const int lr = u.pm * 256 + ai * 128 + wr * 64 + m * 16 + fr;
        const ::bf16_t* gp = P + (size_t)lr * LDP + COL_G + br * DM + u.pn * 256 + wc * 32 + 8 * fq;
#pragma unroll
        for (int bj = 0; bj < 2; ++bj) {
          const u32x4 gi = *(const u32x4*)(gp + bj * 128);
          float sc[8];
#pragma unroll
          for (int k = 0; k < 4; ++k) { sc[2 * k] = bf_lo(gi[k]); sc[2 * k + 1] = bf_hi(gi[k]); }
          if (br < 2) {
            const u32x4 gn = *(const u32x4*)(gp + DM + bj * 128);
#pragma unroll
            for (int k = 0; k < 4; ++k) { sc[2 * k] *= fast_rcp(fmaxf(bf_lo(gn[k]), 1e-30f)); sc[2 * k + 1] *= fast_rcp(fmaxf(bf_hi(gn[k]), 1e-30f)); }
          }
          f32x4 v0 = acc[ai][bj][m][0], v1 = acc[ai][bj][m][1];
          v0[0] *= sc[0]; v0[1] *= sc[1]; v0[2] *= sc[2]; v0[3] *= sc[3]; v1[0] *= sc[4]; v1[1] *= sc[5]; v1[2] *= sc[6]; v1[3] *= sc[7];
          acc[ai][bj][m][0] = v0; acc[ai][bj][m][1] = v1;
          if (br == 2) {
            const int gr = half_grow(hb, lr);
            u32x4 w; w.x = cvtpk(v0[0], v0[1]); w.y = cvtpk(v0[2], v0[3]); w.z = cvtpk(v1[0], v1[1]); w.w = cvtpk(v1[2], v1[3]);
            *(u32x4*)(Y + (size_t)gr * DM + u.pn * 256 + bj * 128 + wc * 32 + 8 * fq) = w;
          }
        }
      }
  }
};
struct EpiGemm1 {
  static constexpr bool PERM = true, AFTER_DRAIN = false;
  ::bf16_t* P; int hb; const float* ropec; const float* ropes;
  __device__ __forceinline__ void operator()(const f32x4 (&acc)[2][2][4][2], const Unit& u, int wr, int wc, int fr, int fq) const {
    const bool latent = u.pm < 128;
    const int lt = latent ? (u.pm - hb * 64) : (64 + (u.pm - 128 - hb * 4));
#pragma unroll
    for (int bj = 0; bj < 2; ++bj) {
      const int cb = u.pn * 256 + bj * 128 + wc * 32;
      int kind = 0;
      if (cb < COL_BQ) kind = 1;
      else if (cb < COL_BV || (cb >= COL_CQ && cb < COL_CV)) kind = latent ? 2 : 0;
      else if (cb >= COL_G) kind = 3;
      const bool qscale = (cb >= COL_BQ && cb < COL_BK) || (cb >= COL_CQ && cb < COL_CK);
      const bool colpart = (wc & 1) != 0;
#pragma unroll
      for (int ai = 0; ai < 2; ++ai)
#pragma unroll
        for (int m = 0; m < 4; ++m) {
          const int lr = lt * 256 + ai * 128 + wr * 64 + m * 16 + fr;
          f32x4 v0 = acc[ai][bj][m][0], v1 = acc[ai][bj][m][1];
          if (kind == 1) {
#pragma unroll
            for (int j = 0; j < 4; ++j) { v0[j] = gelu_tanh(v0[j]); v1[j] = gelu_tanh(v1[j]); }
          } else if (kind == 3) {
#pragma unroll
            for (int j = 0; j < 4; ++j) { v0[j] = sigmoidf_(v0[j]); v1[j] = sigmoidf_(v1[j]); }
          } else if (kind == 2) {
            const int t = lr & (SEQ - 1);
            const int pos = colpart ? (t & 63) : (t >> 6);
            const f32x4 c4 = *(const f32x4*)(ropec + pos * 16 + fq * 4), s4 = *(const f32x4*)(ropes + pos * 16 + fq * 4);
            const f32x4 a1 = v0, a2 = v1;
            v0 = a1 * c4 - a2 * s4; v1 = a2 * c4 + a1 * s4;
          }
          if (qscale) { v0 = v0 * SM_C; v1 = v1 * SM_C; }
          u32x4 w; w.x = cvtpk(v0[0], v0[1]); w.y = cvtpk(v0[2], v0[3]); w.z = cvtpk(v1[0], v1[1]); w.w = cvtpk(v1[2], v1[3]);
          *(u32x4*)(P + (size_t)lr * LDP + cb + fq * 8) = w;
        }
    }
  }
};
struct EpiGateUp {
  static constexpr bool PERM = true, AFTER_DRAIN = false;
  ::bf16_t* Ab; ::bf16_t* Ub;
  __device__ __forceinline__ void operator()(const f32x4 (&acc)[2][2][4][2], const Unit& u, int wr, int wc, int fr, int fq) const {
    const int n0 = u.pn * 256;
    ::bf16_t* O = (n0 < DFF) ? Ab + n0 : Ub + (n0 - DFF);
#pragma unroll
    for (int ai = 0; ai < 2; ++ai)
#pragma unroll
      for (int m = 0; m < 4; ++m) {
        const int gr = u.pm * 256 + ai * 128 + wr * 64 + m * 16 + fr;
        ::bf16_t* orow = O + (size_t)gr * DFF + wc * 32 + 8 * fq;
#pragma unroll
        for (int bj = 0; bj < 2; ++bj) {
          const f32x4 v0 = acc[ai][bj][m][0], v1 = acc[ai][bj][m][1];
          u32x4 w; w.x = cvtpk(v0[0], v0[1]); w.y = cvtpk(v0[2], v0[3]); w.z = cvtpk(v1[0], v1[1]); w.w = cvtpk(v1[2], v1[3]);
          *(u32x4*)(orow + bj * 128) = w;
        }
      }
  }
};
struct EpiResid {
  static constexpr bool PERM = false, AFTER_DRAIN = false;
  const float* gbase;
  const float* lat_src; const float* ctx_src; float* lat_dst; float* ctx_dst;
  __device__ __forceinline__ void operator()(const f32x4 (&acc)[2][2][4][2], const Unit& u, int wr, int wc, int fr, int fq) const {
    const bool latent = u.pm < 128;
    const int mi = latent ? (u.pm >> 4) : 8;
    const float* gv = gbase + (size_t)mi * 6 * DM + u.pn * 256 + wc * 32 + 4 * fq;
    const float* src = latent ? lat_src : ctx_src;
    float* dst = latent ? lat_dst : ctx_dst;
    const int rbase = (latent ? u.pm : u.pm - 128) * 256 + wr * 64 + fr;
#pragma unroll
    for (int bj = 0; bj < 2; ++bj)
#pragma unroll
      for (int n = 0; n < 2; ++n) {
        const f32x4 gg = *(const f32x4*)(gv + bj * 128 + n * 16);
#pragma unroll
        for (int ai = 0; ai < 2; ++ai)
#pragma unroll
          for (int m = 0; m < 4; ++m) {
            const size_t off = (size_t)(rbase + ai * 128 + m * 16) * DM + u.pn * 256 + bj * 128 + wc * 32 + n * 16 + 4 * fq;
            if (u.flags & 2) {
              const f32x4 v = gg * acc[ai][bj][m][n];
#pragma unroll
              for (int j = 0; j < 4; ++j) __hip_atomic_fetch_add(dst + off + j, v[j], __ATOMIC_RELAXED, __HIP_MEMORY_SCOPE_AGENT);
            } else {
              const f32x4 rsd = *(const f32x4*)(src + off);
              *(f32x4*)(dst + off) = rsd + gg * acc[ai][bj][m][n];
            }
          }
      }
  }
};
}

typedef __attribute__((address_space(3))) unsigned char* lds3_t;

DI void gemm1_phase_pg8(const Params& p, int hb, char* lds, int vcu, int G) {
  pg8::Gemm g{DM, DM};
  pg8::TileOrder S{(const char*)(p.ws + WS_H), (const char*)(p.ws + WS_W + W_IN), (size_t)256 * DM * 2, (size_t)256 * DM * 2, DM / 64, INW / 256, (MH / 256) * (INW / 256), G, vcu, hb};
  const float* ropec = (const float*)(p.ws + WS_ROPE);
  pg8::EpiGemm1 E{(bf16_t*)(p.ws + WS_R + R_P), hb, ropec, ropec + 1024};
  pg8::gemm_phase<pg8::EpiGemm1, pg8::TileOrder, true, true>((lds3_t)lds, g, S, E);
}
DI void gateup_phase_pg8(const Params& p, char* lds, int vcu, int G, int mtiles) {
  pg8::Gemm g{DM, DM};
  pg8::TileOrder S{(const char*)(p.ws + WS_H), (const char*)(p.ws + WS_W + W_GU), (size_t)256 * DM * 2, (size_t)256 * DM * 2, DM / 64, 2 * DFF / 256, mtiles * (2 * DFF / 256), G, vcu, -1};
  pg8::EpiGateUp E{(bf16_t*)(p.ws + WS_R + R_A), (bf16_t*)(p.ws + WS_R + R_UP)};
  pg8::gemm_phase<pg8::EpiGateUp, pg8::TileOrder, true, true>((lds3_t)lds, g, S, E);
}
DI void resid_phase_pg8(const Params& p, int l, const bf16_t* A, const bf16_t* Wt, int K, int gidx,
                        const float* lat_src, const float* ctx_src, float* lat_dst, float* ctx_dst, char* lds, int vcu, int G, int mtiles) {
  pg8::Gemm g{K, K};
  pg8::ResidOrder S{(const char*)A, (const char*)Wt, (size_t)256 * K * 2, (size_t)256 * K * 2, K / 64, (mtiles > 128) ? 544 : 512, G, vcu};
  pg8::EpiResid E{(const float*)(p.ws + WS_MOD) + ((size_t)l * 9 * 6 + gidx) * DM, lat_src, ctx_src, lat_dst, ctx_dst};
  pg8::gemm_phase<pg8::EpiResid, pg8::ResidOrder, true, true>((lds3_t)lds, g, S, E);
}
DI void merge_phase_pg8(const Params& p, int hb, char* lds, int vcu, int G, bool last) {
  pg8::Gemm g{LDP, 512};
  pg8::MergeOrder S{(const char*)(p.ws + WS_R + R_P), (const char*)(p.ws + WS_W + W_BR), last ? 256 : 272, G, vcu};
  pg8::EpiMerge E{(const bf16_t*)(p.ws + WS_R + R_P), (bf16_t*)(p.ws + WS_R + R_Y), hb};
  pg8::gemm_phase<pg8::EpiMerge, pg8::MergeOrder, true, true>((lds3_t)lds, g, S, E);
}

#define LAS __attribute__((address_space(3)))
#define XB_TMO      128
#define XB_XCNT(j)  (256  + 64 * (j))
#define XB_XSUB(j)  (1280 + 64 * (j))
#define XB_XGEN(j)  (2304 + 64 * (j))
#define XB_TOP      3328
#define XB_TOPGEN   3392
#define XCD_BAR_WORDS 3456
#define XB_SPIN_CAP (1u << 18)

__device__ __forceinline__ unsigned xb_ld(unsigned* p)              { return __hip_atomic_load(p, __ATOMIC_RELAXED, __HIP_MEMORY_SCOPE_AGENT); }
__device__ __forceinline__ unsigned xb_add(unsigned* p, unsigned v) { return __hip_atomic_fetch_add(p, v, __ATOMIC_RELAXED, __HIP_MEMORY_SCOPE_AGENT); }
__device__ __forceinline__ unsigned xb_xcc_id() { return (unsigned)__builtin_amdgcn_s_getreg((3 << 11) | 20) & 0xFu; }
#define XB_SPIN(cond, bar) do { unsigned _sp = 0; while (cond) { __builtin_amdgcn_s_sleep(1); \
    if ((++_sp & 255u) == 0u) { if (xb_ld(&(bar)[XB_TMO])) break; if (_sp > XB_SPIN_CAP) { atomicAdd(&(bar)[XB_TMO], 1u); break; } } } } while (0)

struct XcdBarrier {
    unsigned* bar; unsigned x;
    volatile LAS unsigned* st;
};

__device__ __forceinline__ XcdBarrier xcd_barrier_post(unsigned* bar, volatile LAS unsigned* st) {
    XcdBarrier b; b.bar = bar; b.x = xb_xcc_id(); b.st = st;
    if (threadIdx.x == 0) (void)xb_add(&bar[XB_XCNT(b.x)], 1u);
    return b;
}
__device__ __forceinline__ void xcd_barrier_complete(unsigned* bar, unsigned x, unsigned& nloc, unsigned& nx) {
    const unsigned G = gridDim.x * gridDim.y * gridDim.z;
    unsigned sum, cnt, mine, sp = 0u;
    for (;;) {
        sum = 0u; cnt = 0u; mine = 0u;
#pragma unroll
        for (unsigned j = 0; j < 16; ++j) { const unsigned c = xb_ld(&bar[XB_XCNT(j)]); sum += c; cnt += (c > 0u) ? 1u : 0u; mine = (j == x) ? c : mine; }
        if (sum == G) break;
        __builtin_amdgcn_s_sleep(1);
        if ((++sp & 255u) == 0u) { if (xb_ld(&bar[XB_TMO])) break; if (sp > XB_SPIN_CAP) { atomicAdd(&bar[XB_TMO], 1u); break; } }
    }
    nloc = mine > 0u ? mine : 1u; nx = cnt > 0u ? cnt : 1u;
}

__device__ __forceinline__ void xcd_barrier(const XcdBarrier& b) {
    asm volatile("s_waitcnt vmcnt(0)" ::: "memory");
    __syncthreads();
    if (threadIdx.x == 0) {
        unsigned* bar = b.bar;
        __builtin_amdgcn_s_waitcnt(0);
        unsigned nloc = b.st[0], nx = b.st[1];
        if (nloc == 0u) { xcd_barrier_complete(bar, b.x, nloc, nx); b.st[0] = nloc; b.st[1] = nx; }
        const unsigned old = xb_add(&bar[XB_XSUB(b.x)], 1u);
        const unsigned gen = old / nloc;
        if (old + 1u == (gen + 1u) * nloc) {
            __builtin_amdgcn_fence(__ATOMIC_RELEASE, "agent");
            asm volatile("s_waitcnt vmcnt(0)" ::: "memory");
            const unsigned og = xb_add(&bar[XB_TOP], 1u);
            const unsigned tg = og / nx;
            if (og + 1u == (tg + 1u) * nx) xb_add(&bar[XB_TOPGEN], 1u);
            else XB_SPIN(xb_ld(&bar[XB_TOPGEN]) == tg, bar);
            __builtin_amdgcn_fence(__ATOMIC_ACQUIRE, "agent");
            xb_add(&bar[XB_XGEN(b.x)], 1u);
            asm volatile("s_waitcnt vmcnt(0)" ::: "memory");
        } else {
            XB_SPIN(xb_ld(&bar[XB_XGEN(b.x)]) == gen, bar);
            __builtin_amdgcn_fence(__ATOMIC_ACQUIRE, "agent");
            asm volatile("s_waitcnt vmcnt(0)" ::: "memory");
        }
    }
    __syncthreads();
}

#define gbar(b_) xcd_barrier(b_)

template <int VD, int NKH, bool GQA>
DI void attn_unit(const Params& p, int l, bf16_t* P, int qrow0, int qcol_base, int kcol0, int kcol1, int vcol, int ocol_base,
                  int ctx_row0, int nctx_t, int lat_row0, int ntiles  , int qpos0, int kpos0, bool masked, float sink_raw0, float sink_raw1,
                  int hd, char* lds) {
  const int tid = opaque_tid(), lane = tid & 63, wave = tid >> 6, r = lane & 31, h = lane >> 5;
  const int qs = wave & 3, sub = wave >> 2;
  constexpr int KP = 144, VP = (VD == 128) ? 320 : 192;
  constexpr int KBYTES = 64 * KP, VBYTES = 64 * VP, STAGE = NKH * KBYTES + VBYTES;
  constexpr int NDB = VD / 32, NVC = VD / 64;
  const int qcol = qcol_base + sub * 64;
  bf16x8 qf[4];
  {
    const bf16_t* qp = P + (size_t)(qrow0 + qs * 32 + r) * LDP + qcol + h * 8;
#pragma unroll
    for (int ds = 0; ds < 4; ++ds) qf[ds] = *(const bf16x8*)(qp + ds * 16);
  }
  const int krow = tid >> 3, kch = tid & 7;
  u32x4 rkA[NKH], rvA[NVC];
  auto tile_row = [&](int t) -> int { return (t < nctx_t) ? ctx_row0 + 64 * t : lat_row0 + 64 * (t - nctx_t); };
#define ATT_LOAD(rk, rv, t_) do { const int tr_ = tile_row(t_); \
    rk[0] = *(const u32x4*)(P + (size_t)(tr_ + krow) * LDP + kcol0 + kch * 8); \
    if (NKH == 2) rk[NKH - 1] = *(const u32x4*)(P + (size_t)(tr_ + krow) * LDP + kcol1 + kch * 8); \
    if (VD == 128) { rv[0] = *(const u32x4*)(P + (size_t)(tr_ + (tid >> 4)) * LDP + vcol + (tid & 15) * 8); \
                     rv[NVC - 1] = *(const u32x4*)(P + (size_t)(tr_ + 32 + (tid >> 4)) * LDP + vcol + (tid & 15) * 8); } \
    else { rv[0] = *(const u32x4*)(P + (size_t)(tr_ + krow) * LDP + vcol + kch * 8); } } while (0)
#define ATT_STORE(rk, rv, st_) do { char* s_ = (st_); \
    *(u32x4*)(s_ + krow * KP + kch * 16) = rk[0]; \
    if (NKH == 2) *(u32x4*)(s_ + KBYTES + krow * KP + kch * 16) = rk[NKH - 1]; \
    if (VD == 128) { *(u32x4*)(s_ + NKH * KBYTES + (tid >> 4) * VP + (tid & 15) * 16) = rv[0]; \
                     *(u32x4*)(s_ + NKH * KBYTES + (32 + (tid >> 4)) * VP + (tid & 15) * 16) = rv[NVC - 1]; } \
    else { *(u32x4*)(s_ + NKH * KBYTES + krow * VP + kch * 16) = rv[0]; } } while (0)

  f32x16 o[NDB];
#pragma unroll
  for (int db = 0; db < NDB; ++db)
#pragma unroll
    for (int i = 0; i < 16; ++i) o[db][i] = 0.f;
  float m = 0.f, lsum = 0.f;
  if (GQA) { const float sk = sub ? sink_raw1 : sink_raw0; lsum = (h == 0) ? ex2(sk * LOG2E) : 0.0f; }
  bool mnz = false;
  const int qpos = qpos0 + qs * 32 + r;
  const int kh = (NKH == 2) ? sub : 0;
  const int q4 = (lane & 15) >> 2, p4 = lane & 3, blk = (lane >> 4) & 1;
  const int voff = (4 * h + q4) * VP + (16 * blk + 4 * p4) * 2;
  const int koff = kh * KBYTES + r * KP + h * 16;

  auto compute = [&](const char* cur, int t) __attribute__((always_inline)) {
    const char* Kb = cur + koff;
    bf16x8 kf[8];
#pragma unroll
    for (int ds = 0; ds < 4; ++ds) { kf[2 * ds] = *(const bf16x8*)(Kb + ds * 32); kf[2 * ds + 1] = *(const bf16x8*)(Kb + 32 * KP + ds * 32); }
    f32x16 zz;
#pragma unroll
    for (int i = 0; i < 16; ++i) zz[i] = 0.f;
    f32x16 s0 = mfma32(kf[0], qf[0], zz), s1 = mfma32(kf[1], qf[0], zz);
#pragma unroll
    for (int ds = 1; ds < 4; ++ds) { s0 = mfma32(kf[2 * ds], qf[ds], s0); s1 = mfma32(kf[2 * ds + 1], qf[ds], s1); }
    const char* Vb = cur + NKH * KBYTES + voff;
    s16x4 vlo[2][4], vhi[2][4];
#pragma unroll
    for (int ks = 0; ks < 4; ++ks) { vlo[0][ks] = tr_read(Vb + (ks * 16) * VP); vhi[0][ks] = tr_read(Vb + (ks * 16 + 8) * VP); }
    __builtin_amdgcn_sched_barrier(0);
    const int tk0 = kpos0 + 64 * (t - nctx_t), wq0 = qpos0 + qs * 32;
    if (GQA && masked && t >= nctx_t && (tk0 + 63 - wq0 > 128 || wq0 + 31 - tk0 > 128)) {
      const int kb0 = kpos0 + 64 * (t - nctx_t) + 4 * h - qpos;
#pragma unroll
      for (int i = 0; i < 16; ++i) {
        const int rel = kb0 + (i & 3) + 8 * (i >> 2);
        if (rel > 128 || rel < -128) s0[i] = -1e30f;
        if (rel + 32 > 128 || rel + 32 < -128) s1[i] = -1e30f;
      }
    }
    if (mnz) {
#pragma unroll
      for (int i = 0; i < 16; ++i) { s0[i] -= m; s1[i] -= m; }
    }
    float mx;
    {
      float a = fmaxf(s0[0], s1[0]), b = fmaxf(s0[1], s1[1]);
#pragma unroll
      for (int i = 2; i < 16; i += 2) { a = __builtin_fmaxf(__builtin_fmaxf(a, s0[i]), s1[i]); b = __builtin_fmaxf(__builtin_fmaxf(b, s0[i + 1]), s1[i + 1]); }
      mx = fmaxf(a, b);
    }
    { const auto rr = __builtin_amdgcn_permlane32_swap(__float_as_uint(mx), __float_as_uint(mx), false, false); mx = fmaxf(__uint_as_float(rr[0]), __uint_as_float(rr[1])); }
    if (__builtin_amdgcn_ballot_w64(mx > 8.0f) != 0) {
      const float d = fmaxf(mx, 0.f);
      const float alpha = ex2(-d);
      m += d; lsum *= alpha;
#pragma unroll
      for (int db = 0; db < NDB; ++db)
#pragma unroll
        for (int i = 0; i < 16; ++i) o[db][i] *= alpha;
#pragma unroll
      for (int i = 0; i < 16; ++i) { s0[i] -= d; s1[i] -= d; }
      mnz = true;
    }
#pragma unroll
    for (int i = 0; i < 16; ++i) { s0[i] = ex2(s0[i]); s1[i] = ex2(s1[i]); }
    {
      f32x2_t a2 = {s0[0], s0[1]}, b2 = {s1[0], s1[1]};
#pragma unroll
      for (int i = 2; i < 16; i += 2) { a2 += (f32x2_t){s0[i], s0[i + 1]}; b2 += (f32x2_t){s1[i], s1[i + 1]}; }
      a2 += b2;
      lsum += a2.x + a2.y;
    }
    bf16x8 pk[4];
    {
      u32x4 w;
      w.x = cvtpk(s0[0], s0[1]); w.y = cvtpk(s0[2], s0[3]); w.z = cvtpk(s0[4], s0[5]); w.w = cvtpk(s0[6], s0[7]); pk[0] = __builtin_bit_cast(bf16x8, w);
      w.x = cvtpk(s0[8], s0[9]); w.y = cvtpk(s0[10], s0[11]); w.z = cvtpk(s0[12], s0[13]); w.w = cvtpk(s0[14], s0[15]); pk[1] = __builtin_bit_cast(bf16x8, w);
      w.x = cvtpk(s1[0], s1[1]); w.y = cvtpk(s1[2], s1[3]); w.z = cvtpk(s1[4], s1[5]); w.w = cvtpk(s1[6], s1[7]); pk[2] = __builtin_bit_cast(bf16x8, w);
      w.x = cvtpk(s1[8], s1[9]); w.y = cvtpk(s1[10], s1[11]); w.z = cvtpk(s1[12], s1[13]); w.w = cvtpk(s1[14], s1[15]); pk[3] = __builtin_bit_cast(bf16x8, w);
    }
#pragma unroll
    for (int db = 0; db < NDB; ++db) {
      if (db + 1 < NDB) {
#pragma unroll
        for (int ks = 0; ks < 4; ++ks) { vlo[(db + 1) & 1][ks] = tr_read(Vb + (ks * 16) * VP + (db + 1) * 64); vhi[(db + 1) & 1][ks] = tr_read(Vb + (ks * 16 + 8) * VP + (db + 1) * 64); }
      }
#pragma unroll
      for (int ks = 0; ks < 4; ++ks) {
        const bf16x8 vf = __builtin_shufflevector(vlo[db & 1][ks], vhi[db & 1][ks], 0, 1, 2, 3, 4, 5, 6, 7);
        o[db] = mfma32(vf, pk[ks], o[db]);
      }
      __builtin_amdgcn_sched_barrier(0);
    }
  };

  ATT_LOAD(rkA, rvA, 0); ATT_STORE(rkA, rvA, lds);
  __syncthreads();
  if (wave >= 4) __builtin_amdgcn_s_setprio(1);
  for (int t = 0; t < ntiles; ++t) {
    char* cur = lds + (t & 1) * STAGE;
    char* nxt = lds + ((t + 1) & 1) * STAGE;
    const bool more = (t + 1) < ntiles;
    if (more) ATT_LOAD(rkA, rvA, t + 1);
    compute(cur, t);
    if (more) ATT_STORE(rkA, rvA, nxt);
    __syncthreads();
  }
#undef ATT_LOAD
#undef ATT_STORE
  __builtin_amdgcn_s_setprio(0);
  lsum += __shfl_xor(lsum, 32);
  const float inv = 1.0f / lsum;
  const int orow = qrow0 + qs * 32 + r;
  if (GQA) {
    bf16_t* op = P + (size_t)orow * LDP + ocol_base + sub * 64 + 4 * h;
#pragma unroll
    for (int db = 0; db < NDB; ++db)
#pragma unroll
      for (int g4 = 0; g4 < 4; ++g4) {
        u32x2 w; w.x = cvtpk(o[db][4 * g4] * inv, o[db][4 * g4 + 1] * inv); w.y = cvtpk(o[db][4 * g4 + 2] * inv, o[db][4 * g4 + 3] * inv);
        *(u32x2*)(op + db * 32 + 8 * g4) = w;
      }
    __syncthreads();
  } else {
    float* xb = (float*)lds + (size_t)qs * (NDB * 16) * 64 + lane;
    if (sub == 1) {
#pragma unroll
      for (int db = 0; db < NDB; ++db)
#pragma unroll
        for (int i = 0; i < 16; ++i) xb[(db * 16 + i) * 64] = o[db][i] * inv;
    }
    __syncthreads();
    if (sub == 0) {
      const float lam = ((const float*)(p.ws + WS_LAM))[l];
      const float lam_init = 0.8f - 0.6f * __expf(-0.3f * (float)l);
      float ss = 0.f;
#pragma unroll
      for (int db = 0; db < NDB; ++db)
#pragma unroll
        for (int i = 0; i < 16; ++i) { const float v = o[db][i] * inv - lam * xb[(db * 16 + i) * 64]; o[db][i] = v; ss += v * v; }
      ss += __shfl_xor(ss, 32);
      const float rstd = (1.0f / sqrtf(ss * (1.0f / VD) + EPS)) * (1.0f - lam_init);
      const float* sg = p.diff_subln_g + l * 128 + 4 * h;
      bf16_t* op = P + (size_t)orow * LDP + ocol_base + 4 * h;
#pragma unroll
      for (int db = 0; db < NDB; ++db)
#pragma unroll
        for (int g4 = 0; g4 < 4; ++g4) {
          const f32x4 gv = *(const f32x4*)(sg + db * 32 + 8 * g4);
          u32x2 w; w.x = cvtpk(o[db][4 * g4] * rstd * gv.x, o[db][4 * g4 + 1] * rstd * gv.y); w.y = cvtpk(o[db][4 * g4 + 2] * rstd * gv.z, o[db][4 * g4 + 3] * rstd * gv.w);
          *(u32x2*)(op + db * 32 + 8 * g4) = w;
        }
    }
    __syncthreads();
  }
}

DI void sgu_unit(const Params& p, int l, bf16_t* P, int lr0, int g, char* lds) {
  const int tid = opaque_tid(), lane = tid & 63, wave = tid >> 6, r16 = lane & 15, quad = lane >> 4;
  constexpr int PITCH = 288;
  char* Al = lds;
  char* Bl = lds + 128 * PITCH;
  float* st = (float*)(lds + 2 * 128 * PITCH);
  {
    const int row = tid >> 2, part = tid & 3;
    const bf16_t* vp = P + (size_t)(lr0 + row) * LDP + COL_AV + part * 128;
    float s = 0.f, s2 = 0.f;
#pragma unroll 4
    for (int i = 0; i < 16; ++i) {
      const u32x4 w = *(const u32x4*)(vp + i * 8);
#pragma unroll
      for (int j = 0; j < 4; ++j) { const float a = bf_lo(w[j]), b = bf_hi(w[j]); s += a + b; s2 += a * a + b * b; }
    }
    s += __shfl_xor(s, 1); s2 += __shfl_xor(s2, 1); s += __shfl_xor(s, 2); s2 += __shfl_xor(s2, 2);
    const float mean = s * (1.0f / 512.0f); const float var = fmaxf(s2 * (1.0f / 512.0f) - mean * mean, 0.f);
    if (part == 0) { st[row * 2] = mean; st[row * 2 + 1] = 1.0f / sqrtf(var + EPS); }
    const float* wsrc = p.w_s + ((size_t)(l * 4 + g) * 128 + row) * 128 + part * 32;
#pragma unroll
    for (int i = 0; i < 4; ++i) {
      const f32x4 a = *(const f32x4*)(wsrc + i * 8), b = *(const f32x4*)(wsrc + i * 8 + 4);
      u32x4 w; w.x = cvtpk(a.x, a.y); w.y = cvtpk(a.z, a.w); w.z = cvtpk(b.x, b.y); w.w = cvtpk(b.z, b.w);
      *(u32x4*)(Al + row * PITCH + (part * 32 + i * 8) * 2) = w;
    }
  }
  __syncthreads();
  {
    const int q = tid & 127, cgp = tid >> 7;
    const float mean = st[q * 2], rstd = st[q * 2 + 1];
    const float* lg = p.sgu_ln_g + l * 512 + g * 128;
    const float* lb = p.sgu_ln_b + l * 512 + g * 128;
#pragma unroll
    for (int ps = 0; ps < 4; ++ps) {
      const int c0 = (cgp + 4 * ps) * 8;
      const u32x4 w = *(const u32x4*)(P + (size_t)(lr0 + q) * LDP + COL_AV + g * 128 + c0);
#pragma unroll
      for (int j = 0; j < 4; ++j) {
        const float a = (bf_lo(w[j]) - mean) * rstd * lg[c0 + 2 * j] + lb[c0 + 2 * j];
        const float b = (bf_hi(w[j]) - mean) * rstd * lg[c0 + 2 * j + 1] + lb[c0 + 2 * j + 1];
        const unsigned pkd = cvtpk(a, b);
        *(bf16_t*)(Bl + (c0 + 2 * j) * PITCH + q * 2) = (bf16_t)(pkd & 0xffffu);
        *(bf16_t*)(Bl + (c0 + 2 * j + 1) * PITCH + q * 2) = (bf16_t)(pkd >> 16);
      }
    }
  }
  __syncthreads();
  const int pw = (wave >> 1) * 32, cw = (wave & 1) * 64;
  f32x4 acc[2][4];
#pragma unroll
  for (int mt = 0; mt < 2; ++mt)
#pragma unroll
    for (int nt = 0; nt < 4; ++nt) acc[mt][nt] = (f32x4){0.f, 0.f, 0.f, 0.f};
#pragma unroll
  for (int ks = 0; ks < 4; ++ks) {
    bf16x8 af[2], bfr[4];
#pragma unroll
    for (int mt = 0; mt < 2; ++mt) af[mt] = *(const bf16x8*)(Al + (pw + mt * 16 + r16) * PITCH + ks * 64 + quad * 16);
#pragma unroll
    for (int nt = 0; nt < 4; ++nt) bfr[nt] = *(const bf16x8*)(Bl + (cw + nt * 16 + r16) * PITCH + ks * 64 + quad * 16);
#pragma unroll
    for (int mt = 0; mt < 2; ++mt)
#pragma unroll
      for (int nt = 0; nt < 4; ++nt) acc[mt][nt] = mfma16(bfr[nt], af[mt], acc[mt][nt]);
  }
#pragma unroll
  for (int mt = 0; mt < 2; ++mt) {
    const int pr = pw + mt * 16 + r16;
    const float bs = p.b_s[(l * 4 + g) * 128 + pr];
    bf16_t* up = P + (size_t)(lr0 + pr) * LDP + COL_AU + g * 128 + cw + quad * 4;
#pragma unroll
    for (int nt = 0; nt < 4; ++nt) {
      const u32x2 uw = *(const u32x2*)(up + nt * 16);
      u32x2 w; w.x = cvtpk(bf_lo(uw.x) * (acc[mt][nt][0] + bs), bf_hi(uw.x) * (acc[mt][nt][1] + bs));
      w.y = cvtpk(bf_lo(uw.y) * (acc[mt][nt][2] + bs), bf_hi(uw.y) * (acc[mt][nt][3] + bs));
      *(u32x2*)(up + nt * 16) = w;
    }
  }
  __syncthreads();
}

DI void mixers_phase(const Params& p, int l, int hb, char* lds, int vcu, int G, bool last) {
  bf16_t* P = (bf16_t*)(p.ws + WS_R + R_P);
  constexpr int N_DL = 512, N_GL = 512;
  const int N_SG = last ? (HALF_LAT / 128) * 4 : (MH / 128) * 4, N_DC = last ? 0 : 32, N_GC = last ? 0 : 32;
#pragma unroll 1
  for (int idx = vcu; idx < N_DL; idx += G) {
    const int bl = idx >> 7, hd = (idx >> 5) & 3, qb = idx & 31;
    attn_unit<128, 2, false>(p, l, P, bl * SEQ + qb * 128, COL_BQ + hd * 128, COL_BK + hd * 128, COL_BK + hd * 128 + 64, COL_BV + hd * 128, COL_BQ + hd * 128,
                             HALF_LAT + bl * NCTX, 4, bl * SEQ, 4 + SEQ / 64, 0, 0, false, 0.f, 0.f, hd, lds);
  }
#pragma unroll 1
  for (int idx = (vcu + G - 32 % G) % G; idx < N_DC; idx += G) {
    const int bl = idx >> 3, hd = (idx >> 1) & 3, qb = idx & 1;
    attn_unit<128, 2, false>(p, l, P, HALF_LAT + bl * NCTX + qb * 128, COL_BQ + hd * 128, COL_BK + hd * 128, COL_BK + hd * 128 + 64, COL_BV + hd * 128, COL_BQ + hd * 128,
                             HALF_LAT + bl * NCTX, 4, 0, 4, 0, 0, false, 0.f, 0.f, hd, lds);
  }
#pragma unroll 1
  for (int idx = vcu; idx < N_GL; idx += G) {
    const int bl = idx >> 7, kvh = (idx >> 6) & 1, n = (idx >> 1) & 31, gp = idx & 1;
    const int start = n * 128;
    const int lo = (start - 128 < 0) ? 0 : start - 128, hi = (start + 256 > SEQ) ? SEQ : start + 256;
    const int hq = kvh * 4 + gp * 2;
    const float sk0 = p.sinks[l * 8 + hq], sk1 = p.sinks[l * 8 + hq + 1];
    attn_unit<64, 1, true>(p, l, P, bl * SEQ + start, COL_CQ + hq * 64, COL_CK + kvh * 64, 0, COL_CV + kvh * 64, COL_CQ + hq * 64,
                           HALF_LAT + bl * NCTX, 4, bl * SEQ + lo, 4 + (hi - lo) / 64, start, lo, true, sk0, sk1, 0, lds);
  }
#pragma unroll 1
  for (int idx = (vcu + G - 64 % G) % G; idx < N_GC; idx += G) {
    const int bl = idx >> 3, kvh = (idx >> 2) & 1, qb = (idx >> 1) & 1, gp = idx & 1;
    const int hq = kvh * 4 + gp * 2;
    const float sk0 = p.sinks[l * 8 + hq], sk1 = p.sinks[l * 8 + hq + 1];
    attn_unit<64, 1, true>(p, l, P, HALF_LAT + bl * NCTX + qb * 128, COL_CQ + hq * 64, COL_CK + kvh * 64, 0, COL_CV + kvh * 64, COL_CQ + hq * 64,
                           HALF_LAT + bl * NCTX, 4, 0, 4, 0, 0, false, sk0, sk1, 0, lds);
  }
#pragma unroll 1
  for (int idx = vcu; idx < N_SG; idx += G) sgu_unit(p, l, P, (idx >> 2) * 128, idx & 3, lds);
}

template <int HB>
DI void half_fwd(const Params& p, int l, const XcdBarrier& bar, char* lds, int vcu, int G) {
  const bool last = (l == DEPTH - 1);
  gemm1_phase_pg8(p, HB, lds, vcu, G);
  gbar(bar);
  mixers_phase(p, l, HB, lds, vcu, G, last);
  gbar(bar);
  merge_phase_pg8(p, HB, lds, vcu, G, last);
  gbar(bar);
}
template <int L>
DI void layer_fwd(const Params& p, const XcdBarrier& bar, char* lds, int vcu, int G) {
  constexpr int l = L;
  constexpr int nrows = (L == DEPTH - 1) ? NLAT : MTOT;
  float* ctxs = (float*)(p.ws + WS_CTX);
  const float* lat_src = (l == 0) ? p.x : p.out;
  const float* ctx_src = ctxs;
  if (l > 0) convert_weights(p, l, lds, vcu, G);
  norm_phase(p, l, 0, lat_src, ctx_src, vcu, G, MTOT);
  gbar(bar);
  half_fwd<0>(p, l, bar, lds, vcu, G);
  half_fwd<1>(p, l, bar, lds, vcu, G);
  resid_phase_pg8(p, l, (const bf16_t*)(p.ws + WS_R + R_Y), (const bf16_t*)(p.ws + WS_W + W_OUT), DM, 2, lat_src, ctx_src, p.out, ctxs, lds, vcu, G, nrows / 256);
  gbar(bar);
  norm_phase(p, l, 1, p.out, ctxs, vcu, G, nrows);
  gbar(bar);
  gateup_phase_pg8(p, lds, vcu, G, nrows / 256);
  gbar(bar);
  conv_phase(p, l, vcu, G, nrows);
  gbar(bar);
  resid_phase_pg8(p, l, (const bf16_t*)(p.ws + WS_R + R_UP), (const bf16_t*)(p.ws + WS_W + W_DN), DFF, 5, p.out, ctxs, p.out, ctxs, lds, vcu, G, nrows / 256);
  gbar(bar);
}

__global__ void __launch_bounds__(512) mega_fwd(Params p) {
  extern __shared__ __attribute__((aligned(16))) unsigned char lds_raw[];
  char* lds = (char*)lds_raw;
  cg::grid_group grid = cg::this_grid();
  const int tid = opaque_tid();
  const int G = gridDim.x, bx = blockIdx.x;
  int vcu = (G % 8 == 0) ? (bx % 8) * (G / 8) + bx / 8 : bx;
  float* ctxs = (float*)(p.ws + WS_CTX);
  if (tid < 64) ((LAS unsigned*)(lds_raw + LDS_MISC))[tid] = 0u;
  __syncthreads();
  unsigned* xcnt = (unsigned*)(p.ws + WS_BAR + 14336);
  const unsigned myx = xb_xcc_id();
  if (tid == 0) ((LAS unsigned*)(lds_raw + LDS_MISC))[16] = __hip_atomic_fetch_add(xcnt + myx, 1u, __ATOMIC_RELAXED, __HIP_MEMORY_SCOPE_AGENT);
  const XcdBarrier bar = xcd_barrier_post((unsigned*)(p.ws + WS_BAR), (volatile LAS unsigned*)(lds_raw + LDS_MISC) + 8);

  if (bx == 0) {
    float* rc = (float*)(p.ws + WS_ROPE);
    for (int e = tid; e < 1024; e += 512) {
      const int pos = e >> 4, i = e & 15;
      const float inv = powf(10000.0f, -(float)(2 * i) / 32.0f);
      const float ang = (float)pos * inv;
      rc[e] = cosf(ang); rc[1024 + e] = sinf(ang);
    }
  }
  if (bx == 1 && tid < DEPTH) {
    float s1 = 0.f, s2 = 0.f;
    for (int i = 0; i < 64; ++i) { s1 += p.lam_q1[tid * 64 + i] * p.lam_k1[tid * 64 + i]; s2 += p.lam_q2[tid * 64 + i] * p.lam_k2[tid * 64 + i]; }
    const float lam_init = 0.8f - 0.6f * expf(-0.3f * (float)tid);
    ((float*)(p.ws + WS_LAM))[tid] = expf(s1) - expf(s2) + lam_init;
  }
  for (int i = vcu * 512 + tid; i < NCTXR * DM / 4; i += G * 512) ((f32x4*)ctxs)[i] = ((const f32x4*)p.ctx)[i];
  ada_phase(p, lds, vcu, G);
  convert_weights(p, 0, lds, vcu, G);
  grid.sync();
  {
    if (tid == 0) {
      unsigned pre = 0u;
      for (unsigned j = 0; j < 16u; ++j) { const unsigned cj = __hip_atomic_load(xcnt + j, __ATOMIC_RELAXED, __HIP_MEMORY_SCOPE_AGENT); if (j < myx) pre += cj; }
      ((LAS unsigned*)(lds_raw + LDS_MISC))[17] = pre + ((LAS unsigned*)(lds_raw + LDS_MISC))[16];
    }
    __syncthreads();
    vcu = (int)((LAS unsigned*)(lds_raw + LDS_MISC))[17];
    vcu = __builtin_amdgcn_readfirstlane(vcu);
  }

  layer_fwd<0>(p, bar, lds, vcu, G);
  layer_fwd<1>(p, bar, lds, vcu, G);
  layer_fwd<2>(p, bar, lds, vcu, G);
  layer_fwd<3>(p, bar, lds, vcu, G);
  const int tid2 = opaque_tid(), lane = tid2 & 63;
  for (int row = vcu * 8 + (tid2 >> 6); row < NLAT; row += G * 8) {
    float* xr = p.out + (size_t)row * DM;
    f32x4 v[4]; float ss = 0.f;
#pragma unroll
    for (int j = 0; j < 4; ++j) { v[j] = ((const f32x4*)xr)[lane + 64 * j]; ss += (v[j].x * v[j].x + v[j].y * v[j].y) + (v[j].z * v[j].z + v[j].w * v[j].w); }
    const float rstd = 1.0f / sqrtf(wave_sum(ss) * (1.0f / DM) + EPS);
#pragma unroll
    for (int j = 0; j < 4; ++j) { const f32x4 gg = ((const f32x4*)p.final_g)[lane + 64 * j]; ((f32x4*)xr)[lane + 64 * j] = v[j] * rstd * gg; }
  }
}

extern "C" void kernel_launch(void* const* d_in, const int* in_sizes, int n_in, void* d_out, int out_size, void* d_ws, size_t ws_size, hipStream_t stream) {
  static int grid = 0;
  if (grid == 0) {
    if (n_in != 27 || in_sizes[0] != NLAT * DM || out_size != NLAT * DM || ws_size < WS_END) {
      fprintf(stderr, "kernel_launch: unexpected shapes (n_in %d, in0 %d, out %d, ws %zu, need %zu)\n", n_in, n_in > 0 ? in_sizes[0] : -1, out_size, ws_size, (size_t)WS_END);
      grid = -1; return;
    }
    int dev = 0, cus = 0, per_cu = 0;
    hipGetDevice(&dev);
    hipDeviceGetAttribute(&cus, hipDeviceAttributeMultiprocessorCount, dev);
    hipFuncSetAttribute((const void*)mega_fwd, hipFuncAttributeMaxDynamicSharedMemorySize, LDS_BYTES);
    hipOccupancyMaxActiveBlocksPerMultiprocessor(&per_cu, (const void*)mega_fwd, 512, LDS_BYTES);
    if (per_cu < 1) per_cu = 1;
    grid = cus * per_cu;
  }
  if (grid < 0) return;
  Params p{};
  const float** pp = (const float**)&p;
  for (int i = 0; i < 27; ++i) pp[i] = (const float*)d_in[i];
  p.out = (float*)d_out; p.ws = (unsigned char*)d_ws;
  (void)hipMemsetAsync((unsigned char*)d_ws + WS_BAR, 0, 16384, stream);
  void* args[] = {&p};
  hipError_t e = hipLaunchCooperativeKernel((const void*)mega_fwd, dim3(grid), dim3(512), args, LDS_BYTES, stream);
  if (e != hipSuccess) fprintf(stderr, "cooperative launch failed: %s (grid %d)\n", hipGetErrorString(e), grid);
}
```
